# Optimizing an MI355X kernel written in HIP

```python
import jax, jax.numpy as jnp
from jax import lax
import numpy as np

D_MODEL = 1024
BATCH = 16
SEQ = 4096
DEPTH = 4

NUM_MIXERS = 3
HEAD_DIM = 128
D_INNER = 2 * D_MODEL
MEM_HEADS = 4
MEM_LEN = 256
MIX_HEADS = D_INNER // HEAD_DIM - MEM_HEADS
A_KV_HEADS = MIX_HEADS // 3
A_GROUP = MIX_HEADS // A_KV_HEADS
A_WINDOW = 128
B_GROUPS = ((128, 1), (512, 4), (2048, 16))
NA_ROWS = 8
NA_COLS = 16
GRID_W = 64
ROPE_THETA = 500000.0
ROPE_DIMS = HEAD_DIM // 4
LN_EPS = 1e-5
ALPHA = (2 * DEPTH) ** 0.25
BETA = (8 * DEPTH) ** -0.25
NEG_INF = -1e30
N_A = len(range(0, DEPTH, NUM_MIXERS))
N_B = len(range(1, DEPTH, NUM_MIXERS))
N_C = len(range(2, DEPTH, NUM_MIXERS))
SPLIT_A = (MIX_HEADS * HEAD_DIM, A_KV_HEADS * HEAD_DIM, A_KV_HEADS * HEAD_DIM, MEM_HEADS * HEAD_DIM, D_INNER)
SPLIT_B = (len(B_GROUPS) * MIX_HEADS * HEAD_DIM, MIX_HEADS * HEAD_DIM, MIX_HEADS * HEAD_DIM, MEM_HEADS * HEAD_DIM, D_INNER)
SPLIT_C = (MIX_HEADS * HEAD_DIM, MIX_HEADS * HEAD_DIM, MIX_HEADS * HEAD_DIM, MEM_HEADS * HEAD_DIM, D_INNER)

kernel_name = "hybrid_window_dilated_neighborhood_encoder"


def layer_norm(x, g, b):
    xf = x.astype(jnp.float32)
    mu = jnp.mean(xf, axis=-1, keepdims=True)
    var = jnp.mean(jnp.square(xf - mu), axis=-1, keepdims=True)
    y = (xf - mu) * lax.rsqrt(var + LN_EPS) * g.astype(jnp.float32) + b.astype(jnp.float32)
    return y.astype(x.dtype)


def split_proj(h, sizes):
    idx = np.cumsum(sizes)[:-1].tolist()
    return jnp.split(h, idx, axis=-1)


def to_heads(t, n):
    b, l, _ = t.shape
    return t.reshape(b, l, n, HEAD_DIM).transpose(0, 2, 1, 3)


def apply_rope(x, pos):
    half = ROPE_DIMS // 2
    inv = ROPE_THETA ** (-jnp.arange(half, dtype=jnp.float32) / half)
    ang = pos.astype(jnp.float32)[:, None] * inv[None, :]
    cos, sin = jnp.cos(ang).astype(x.dtype), jnp.sin(ang).astype(x.dtype)
    x1, x2, rest = x[..., :half], x[..., half:ROPE_DIMS], x[..., ROPE_DIMS:]
    return jnp.concatenate([x1 * cos - x2 * sin, x2 * cos + x1 * sin, rest], axis=-1)


def band_attention(q, k, v, w, sink=None, return_lse=False):
    L, dh = q.shape[-2], q.shape[-1]
    nb = -(-L // w)
    pad = nb * w - L
    lead_q, lead_k = q.shape[:-2], k.shape[:-2]
    qb = jnp.pad(q, [(0, 0)] * len(lead_q) + [(0, pad), (0, 0)]).reshape(lead_q + (nb, w, dh))

    def blocks3(t):
        tp = jnp.pad(t, [(0, 0)] * len(lead_k) + [(w, w + pad), (0, 0)]).reshape(lead_k + (nb + 2, w, dh))
        return jnp.concatenate([tp[..., :-2, :, :], tp[..., 1:-1, :, :], tp[..., 2:, :, :]], axis=-2)

    kb, vb = blocks3(k), blocks3(v)
    s = jnp.einsum('...gnid,...njd->...gnij', qb, kb).astype(jnp.float32) * (dh ** -0.5)
    blk = jnp.arange(nb)[:, None, None]
    t_pos = blk * w + jnp.arange(w)[None, :, None]
    s_pos = (blk - 1) * w + jnp.arange(3 * w)[None, None, :]
    valid = (jnp.abs(s_pos - t_pos) <= w) & (s_pos >= 0) & (s_pos < L)
    s = jnp.where(valid, s, NEG_INF)
    m = jnp.max(s, axis=-1, keepdims=True)
    if sink is not None:
        m = jnp.maximum(m, sink)
    p = jnp.exp(s - m)
    z = jnp.sum(p, axis=-1, keepdims=True)
    if sink is not None:
        z = z + jnp.exp(sink - m)
    o = jnp.einsum('...gnij,...njd->...gnid', (p / z).astype(v.dtype), vb)
    o = o.reshape(lead_q + (nb * w, dh))[..., :L, :]
    if return_lse:
        lse = (m + jnp.log(z))[..., 0].reshape(lead_q + (nb * w,))[..., :L]
        return o, lse
    return o


def dilate(t, d):
    L, D = t.shape[-2], t.shape[-1]
    return t.reshape(t.shape[:-2] + (L // d, d, D)).swapaxes(-3, -2)


def undilate(t, d):
    n, D = t.shape[-2], t.shape[-1]
    return t.swapaxes(-3, -2).reshape(t.shape[:-3] + (n * d, D))


def undilate_rows(t, d):
    n = t.shape[-1]
    return t.swapaxes(-2, -1).reshape(t.shape[:-2] + (n * d,))


def mixer_a(q, k, v, sink, pos):
    b, _, l, _ = q.shape
    q, k = apply_rope(q, pos), apply_rope(k, pos)
    qg = q.reshape(b, A_KV_HEADS, A_GROUP, l, HEAD_DIM)
    s = sink.astype(jnp.float32).reshape(A_KV_HEADS, A_GROUP, 1, 1, 1)
    o = band_attention(qg, k, v, A_WINDOW, sink=s)
    return o.reshape(b, MIX_HEADS, l, HEAD_DIM)


def mixer_b(q, k, v, pos):
    q, k = apply_rope(q, pos), apply_rope(k, pos)
    outs, lses = [], []
    for g, (window, dil) in enumerate(B_GROUPS):
        qg = q[:, g * MIX_HEADS:(g + 1) * MIX_HEADS]
        o, lse = band_attention(dilate(qg, dil)[..., None, :, :], dilate(k, dil), dilate(v, dil),
                                window // (2 * dil), return_lse=True)
        outs.append(undilate(o[..., 0, :, :], dil))
        lses.append(undilate_rows(lse[..., 0, :], dil))
    wts = jax.nn.softmax(jnp.stack(lses), axis=0)
    o = jnp.einsum('gbhl,gbhld->bhld', wts, jnp.stack(outs).astype(jnp.float32))
    return o.astype(q.dtype)


def mixer_c(q, k, v, rpb):
    b, h, L, dh = q.shape
    rows = L // GRID_W
    kh, kw = min(NA_ROWS, rows), NA_COLS
    kr, kc = 2 * kh - 1, 2 * kw - 1
    nrb, ncb = -(-rows // kh), GRID_W // kw
    qg = jnp.pad(q.reshape(b, h, rows, GRID_W, dh), ((0, 0), (0, 0), (0, nrb * kh - rows), (0, 0), (0, 0)))
    qb = qg.reshape(b, h, nrb, kh, ncb, kw, dh).transpose(0, 1, 2, 4, 3, 5, 6)
    qrow = jnp.arange(nrb * kh)
    qcol = jnp.arange(GRID_W)
    rs = jnp.clip(qrow - kh // 2, 0, rows - kh)
    cs = jnp.clip(qcol - kw // 2, 0, GRID_W - kw)
    krow = rs[::kh][:, None] + jnp.arange(kr)[None, :]
    kcol = cs[::kw][:, None] + jnp.arange(kc)[None, :]
    ridx = jnp.minimum(krow, rows - 1)
    cidx = jnp.minimum(kcol, GRID_W - 1)
    kg = k.reshape(b, h, rows, GRID_W, dh)
    vg = v.reshape(b, h, rows, GRID_W, dh)
    gi_r, gi_c = ridx[:, None, :, None], cidx[None, :, None, :]
    kb = kg[:, :, gi_r, gi_c].reshape(b, h, nrb, ncb, kr * kc, dh)
    vb = vg[:, :, gi_r, gi_c].reshape(b, h, nrb, ncb, kr * kc, dh)
    qr = qrow.reshape(nrb, kh)
    qc = qcol.reshape(ncb, kw)
    rsq, csq = rs.reshape(nrb, kh), cs.reshape(ncb, kw)
    rv = (krow[:, None, :] >= rsq[:, :, None]) & (krow[:, None, :] < rsq[:, :, None] + kh)
    cv = (kcol[:, None, :] >= csq[:, :, None]) & (kcol[:, None, :] < csq[:, :, None] + kw)
    mask = rv[:, None, :, None, :, None] & cv[None, :, None, :, None, :]
    dri = jnp.clip(krow[:, None, :] - qr[:, :, None] + NA_ROWS - 1, 0, 2 * NA_ROWS - 2)
    dci = jnp.clip(kcol[:, None, :] - qc[:, :, None] + NA_COLS - 1, 0, 2 * NA_COLS - 2)
    bias = rpb.astype(jnp.float32)[:, dri[:, None, :, None, :, None], dci[None, :, None, :, None, :]]
    s = jnp.einsum('bhnmijd,bhnmkd->bhnmijk', qb, kb).astype(jnp.float32) * (dh ** -0.5)
    s = s + bias.reshape((h, nrb, ncb, kh, kw, kr * kc))[None]
    s = jnp.where(mask.reshape(nrb, ncb, kh, kw, kr * kc), s, NEG_INF)
    p = jax.nn.softmax(s, axis=-1).astype(v.dtype)
    o = jnp.einsum('bhnmijk,bhnmkd->bhnmijd', p, vb)
    o = o.transpose(0, 1, 2, 4, 3, 5, 6).reshape(b, h, nrb * kh, GRID_W, dh)[:, :, :rows]
    return o.reshape(b, h, L, dh)


def memory_attention(mq, mem, w_mkv):
    mk, mv = jnp.split(jnp.einsum('bmd,de->bme', mem, w_mkv), 2, axis=-1)
    mk, mv = to_heads(mk, MEM_HEADS), to_heads(mv, MEM_HEADS)
    s = jnp.einsum('bhld,bhmd->bhlm', mq, mk).astype(jnp.float32) * (HEAD_DIM ** -0.5)
    p = jax.nn.softmax(s, axis=-1).astype(mv.dtype)
    return jnp.einsum('bhlm,bhmd->bhld', p, mv)


def setup_inputs(seed: int = 0) -> dict:
    key = jax.random.key(seed)
    ks = jax.random.split(key, 12)
    nrm = jax.random.normal
    f32 = jnp.float32
    x = nrm(ks[0], (BATCH, SEQ, D_MODEL), f32)
    mem = nrm(ks[1], (BATCH, MEM_LEN, D_MODEL), f32)
    w_in_a = nrm(ks[2], (N_A, D_MODEL, sum(SPLIT_A)), f32) * D_MODEL ** -0.5
    sink_a = nrm(ks[3], (N_A, MIX_HEADS), f32)
    w_in_b = nrm(ks[4], (N_B, D_MODEL, sum(SPLIT_B)), f32) * D_MODEL ** -0.5
    w_in_c = nrm(ks[5], (N_C, D_MODEL, sum(SPLIT_C)), f32) * D_MODEL ** -0.5
    rpb_c = nrm(ks[6], (N_C, MIX_HEADS, 2 * NA_ROWS - 1, 2 * NA_COLS - 1), f32) * 0.1
    w_mkv = nrm(ks[7], (DEPTH, D_MODEL, 2 * MEM_HEADS * HEAD_DIM), f32) * D_MODEL ** -0.5
    w_out = nrm(ks[8], (DEPTH, D_INNER, D_MODEL), f32) * (D_INNER ** -0.5 * BETA)
    ln_g = 1.0 + 0.05 * nrm(ks[9], (DEPTH, D_MODEL), f32)
    ln_b = 0.02 * nrm(ks[10], (DEPTH, D_MODEL), f32)
    return {"x": x, "mem": mem, "w_in_a": w_in_a, "sink_a": sink_a, "w_in_b": w_in_b,
            "w_in_c": w_in_c, "rpb_c": rpb_c, "w_mkv": w_mkv, "w_out": w_out,
            "ln_g": ln_g, "ln_b": ln_b}


def reference(x, mem, w_in_a, sink_a, w_in_b, w_in_c, rpb_c, w_mkv, w_out, ln_g, ln_b):
    b, L, _ = x.shape
    pos = jnp.arange(L)
    for i in range(DEPTH):
        kind, j = i % NUM_MIXERS, i // NUM_MIXERS
        if kind == 0:
            q, k, v, mq, gate = split_proj(jnp.einsum('bld,de->ble', x, w_in_a[j]), SPLIT_A)
            o_mix = mixer_a(to_heads(q, MIX_HEADS), to_heads(k, A_KV_HEADS), to_heads(v, A_KV_HEADS), sink_a[j], pos)
        elif kind == 1:
            q, k, v, mq, gate = split_proj(jnp.einsum('bld,de->ble', x, w_in_b[j]), SPLIT_B)
            o_mix = mixer_b(to_heads(q, len(B_GROUPS) * MIX_HEADS), to_heads(k, MIX_HEADS), to_heads(v, MIX_HEADS), pos)
        else:
            q, k, v, mq, gate = split_proj(jnp.einsum('bld,de->ble', x, w_in_c[j]), SPLIT_C)
            o_mix = mixer_c(to_heads(q, MIX_HEADS), to_heads(k, MIX_HEADS), to_heads(v, MIX_HEADS), rpb_c[j])
        o_mem = memory_attention(to_heads(mq, MEM_HEADS), mem, w_mkv[i])
        y = jnp.concatenate([o_mix, o_mem], axis=1).transpose(0, 2, 1, 3).reshape(b, L, D_INNER)
        y = y * jax.nn.silu(gate)
        branch = jnp.einsum('ble,ed->bld', y, w_out[i])
        x = layer_norm(ALPHA * x + branch, ln_g[i], ln_b[i])
    return x
```

```cpp
#include <hip/hip_runtime.h>
#include <hip/hip_cooperative_groups.h>
#include <hip/hip_bf16.h>
#include <cstdio>
#include <cstdint>
namespace cg = cooperative_groups;
namespace pg8 {
#define PG8_LAS __attribute__((address_space(3)))
typedef unsigned short bf16_t;
typedef short bf16x8 __attribute__((ext_vector_type(8)));
typedef float f32x4 __attribute__((ext_vector_type(4)));
typedef unsigned u32x4 __attribute__((ext_vector_type(4)));
constexpr int BM = 256, BK = 64, HALF = 128, HTB = HALF * BK * 2  , STAGE_BYTES = 8 * HTB, NXCD = 8, WGM = 8;

__host__ __device__ __forceinline__ int lds_byte(int r, int c) { const int st = (r >> 4) * 2 + (c >> 5), rr = r & 15, cc = c & 31, ob = rr * 64 + cc * 2; return st * 1024 + (ob ^ (((ob >> 9) & 1) << 5)); }
__host__ __device__ __forceinline__ void stage_rc(int b, int& R, int& C) { const int st = b / 1024, sb = b % 1024, swz = sb ^ (((sb >> 9) & 1) << 5); R = (st >> 1) * 16 + swz / 64; C = (st & 1) * 32 + (swz % 64) / 2; }
__host__ __device__ __forceinline__ int perm32(int rho) { const int n = rho >> 4, i = rho & 15; return 8 * (i >> 2) + 4 * n + (i & 3); }

struct Unit { int pm, pn; };
struct Gemm { const bf16_t* A; const bf16_t* Bt; int M, N, K; };

struct StaticOrder {
    int nM, nN, nwg, G, c;
    __host__ __device__ void init(int M, int N, int G_, int c_) { nM = M / BM; nN = N / BM; nwg = nM * nN; G = G_; c = c_; }
    __host__ __device__ bool next(int i, Unit& u) const {
        const long L = (long)i * G + c; if (L >= nwg) return false;
        int wgid = (int)L; { const int q = nwg / NXCD, r = nwg % NXCD, xcd = wgid % NXCD, off = wgid / NXCD; wgid = (xcd < r ? xcd * (q + 1) : r * (q + 1) + (xcd - r) * q) + off; }
        const int nig = WGM * nN, gid = wgid / nig, fm = gid * WGM, gsz = (nM - fm) < WGM ? (nM - fm) : WGM;
        u.pm = fm + ((wgid % nig) % gsz); u.pn = (wgid % nig) / gsz; return true;
    }
    __device__ __forceinline__ void a_ready(const Unit&) const {}
    __device__ __forceinline__ void done(const Unit&) const {}
};

__device__ __forceinline__ unsigned cvt_pk_bf16(float lo, float hi) { unsigned r; asm volatile("v_cvt_pk_bf16_f32 %0, %1, %2" : "=v"(r) : "v"(lo), "v"(hi)); return r; }
typedef float f32x2 __attribute__((ext_vector_type(2)));
__device__ __forceinline__ f32x2 gelu_pk(f32x2 v) {
    const f32x2 av = __builtin_elementwise_abs(v), d = av * 0.2316418882f + 1.0f;
    f32x2 t; t.x = __builtin_amdgcn_rcpf(d.x); t.y = __builtin_amdgcn_rcpf(d.y);
    f32x2 q = t * 0.5307027145f + (-0.7265760135f); q = q * t + 0.7107068705f; q = q * t + (-0.142248368f); q = q * t + 0.127414796f; q = q * t;
    const f32x2 s = (v * v) * (-0.72134752044f);
    f32x2 e; e.x = __builtin_amdgcn_exp2f(s.x); e.y = __builtin_amdgcn_exp2f(s.y);
    const f32x2 m = v * (q * e), r = v - m;
    f32x2 o; o.x = v.x < 0.f ? m.x : r.x; o.y = v.y < 0.f ? m.y : r.y; return o;
}

template <int ACT  > struct EpiBf16 {
    static constexpr bool PERM = true, AFTER_DRAIN = false; static_assert(ACT == 0 || ACT == 1, "EpiBf16: ACT is 0 (none) or 1 (gelu_pk)");
    bf16_t* O; int ldc; const float* bias; int split_cols; size_t split_stride; float scale0;
    __device__ __forceinline__ void operator()(const f32x4 (&acc)[2][2][4][2], const Unit& u, int wr, int wc, int fr, int fq) const {
        const int row0 = u.pm * BM + wr * 64 + fr; int colt = u.pn * BM; bf16_t* base = O;
        float sc = 1.f; if (split_cols) { const int t = colt / split_cols; base += (size_t)t * split_stride; colt -= t * split_cols; if (t == 0) sc = scale0; }
        const int col0 = colt + wc * 32 + 8 * fq, bcol0 = u.pn * BM + wc * 32 + 8 * fq;
        f32x4 bv[2][2];
#pragma unroll
        for (int bj = 0; bj < 2; ++bj)
#pragma unroll
            for (int n = 0; n < 2; ++n) bv[bj][n] = bias ? *(const f32x4*)(bias + bcol0 + bj * HALF + 4 * n) : (f32x4){0.f, 0.f, 0.f, 0.f};
#pragma unroll
        for (int ai = 0; ai < 2; ++ai)
#pragma unroll
            for (int m = 0; m < 4; ++m) { bf16_t* rowp = base + (size_t)(row0 + ai * HALF + m * 16) * ldc + col0;
#pragma unroll
                for (int bj = 0; bj < 2; ++bj) { f32x4 v0 = acc[ai][bj][m][0] + bv[bj][0], v1 = acc[ai][bj][m][1] + bv[bj][1];
                    if (ACT == 1) { f32x2 a = gelu_pk((f32x2){v0[0], v0[1]}), b = gelu_pk((f32x2){v0[2], v0[3]}), c = gelu_pk((f32x2){v1[0], v1[1]}), d = gelu_pk((f32x2){v1[2], v1[3]});
                        v0 = (f32x4){a.x, a.y, b.x, b.y}; v1 = (f32x4){c.x, c.y, d.x, d.y}; }
                    v0 = v0 * sc; v1 = v1 * sc; u32x4 w; w.x = cvt_pk_bf16(v0[0], v0[1]); w.y = cvt_pk_bf16(v0[2], v0[3]); w.z = cvt_pk_bf16(v1[0], v1[1]); w.w = cvt_pk_bf16(v1[2], v1[3]);
                    *(u32x4*)(rowp + bj * HALF) = w; } }
    }
};

struct PanelStats {
    unsigned* xbuf;
    unsigned* cnt;
    unsigned* tmo;
    int ntn; float eps;
    unsigned code;
    __device__ __forceinline__ bool run(const f32x4 (&v)[2][2][4][2], const Unit& u, int wr, int wc, int fr, int fq, PG8_LAS unsigned char* lds, int wid, int lane) const {
        typedef float f32x2v __attribute__((ext_vector_type(2)));
        PG8_LAS f32x2v* P = (PG8_LAS f32x2v*)lds;
        PG8_LAS f32x2v* S = (PG8_LAS f32x2v*)(lds + 8192);
        PG8_LAS unsigned* flag = (PG8_LAS unsigned*)(lds + 8192 + 2048);
#pragma unroll
        for (int ai = 0; ai < 2; ++ai)
#pragma unroll
            for (int m = 0; m < 4; ++m) {
                float s = 0.f;
#pragma unroll
                for (int bj = 0; bj < 2; ++bj)
#pragma unroll
                    for (int n = 0; n < 2; ++n) { const f32x4 x = v[ai][bj][m][n]; s += (x[0] + x[1]) + (x[2] + x[3]); }
                s += __shfl_xor(s, 16); s += __shfl_xor(s, 32);
                const float mw = s * (1.0f / 64.0f); float q = 0.f;
#pragma unroll
                for (int bj = 0; bj < 2; ++bj)
#pragma unroll
                    for (int n = 0; n < 2; ++n) { const f32x4 d = v[ai][bj][m][n] - mw; q += (d[0] * d[0] + d[1] * d[1]) + (d[2] * d[2] + d[3] * d[3]); }
                q += __shfl_xor(q, 16); q += __shfl_xor(q, 32);
                if (fq == 0) P[(ai * HALF + wr * 64 + m * 16 + fr) * 4 + wc] = (f32x2v){mw, q};
            }
        asm volatile("s_waitcnt lgkmcnt(0)" ::: "memory"); __builtin_amdgcn_s_barrier(); asm volatile("" ::: "memory");
#if defined(BROKEN_EXCHANGE_NO_WAIT)
#warning BROKEN CONTROL BUILD: the row-statistics exchange does not wait; results are wrong by design
        if (blockIdx.x >= 64) { const long long t0_ = clock64(); while (clock64() - t0_ < 60000) __builtin_amdgcn_s_sleep(8); }
#endif
        const int row = wid * 32 + (lane & 31);
        if (lane < 32) {
            const f32x2v a = P[row * 4 + 0], b = P[row * 4 + 1], c = P[row * 4 + 2], d = P[row * 4 + 3];
            const float mt = (a.x + b.x + c.x + d.x) * 0.25f;
            const float da = a.x - mt, db = b.x - mt, dc = c.x - mt, dd = d.x - mt;
            const float m2 = (a.y + b.y) + (c.y + d.y) + 64.0f * ((da * da + db * db) + (dc * dc + dd * dd));
            unsigned long long* slot = (unsigned long long*)xbuf + ((size_t)(u.pm * BM + row) * 4 + u.pn);
            __hip_atomic_store(slot, ((unsigned long long)__float_as_uint(m2) << 32) | __float_as_uint(mt), __ATOMIC_RELAXED, __HIP_MEMORY_SCOPE_AGENT);
        }
        asm volatile("s_waitcnt vmcnt(0)" ::: "memory");
        if (lane == 0) __hip_atomic_fetch_add(cnt + 64 * u.pm, 1u, __ATOMIC_RELAXED, __HIP_MEMORY_SCOPE_AGENT);
        if (wid == 0) {
            bool dead = false; const unsigned long long t0 = __builtin_amdgcn_s_memrealtime(); const unsigned want = 8u * (unsigned)ntn;
            for (;;) {
#if defined(BROKEN_EXCHANGE_NO_WAIT)
                break;
#endif
                if ((unsigned)__builtin_amdgcn_readfirstlane(__hip_atomic_load(cnt + 64 * u.pm, __ATOMIC_RELAXED, __HIP_MEMORY_SCOPE_AGENT)) >= want) break;
                if (__builtin_amdgcn_s_memrealtime() - t0 > 2000000ull) {
                    if (lane == 0) { unsigned expect = 0u; __hip_atomic_compare_exchange_strong(tmo + 1, &expect, code | (unsigned)(u.pm & 0xff), __ATOMIC_RELAXED, __ATOMIC_RELAXED, __HIP_MEMORY_SCOPE_AGENT);
                                     __hip_atomic_store(tmo, 1u, __ATOMIC_RELAXED, __HIP_MEMORY_SCOPE_AGENT); }
                    dead = true; break; }
                __builtin_amdgcn_s_sleep(2);
            }
            __builtin_amdgcn_fence(__ATOMIC_ACQUIRE, "agent");
            if (lane == 0) flag[0] = dead ? 1u : 0u;
        }
        asm volatile("s_waitcnt vmcnt(0) lgkmcnt(0)" ::: "memory"); __builtin_amdgcn_s_barrier(); asm volatile("" ::: "memory");
        const bool bad = flag[0] != 0u;
        if (lane < 32) {
            const unsigned long long* slot = (const unsigned long long*)xbuf + (size_t)(u.pm * BM + row) * 4; float mt[4], m2[4]; float ms = 0.f;
#pragma unroll
            for (int t = 0; t < 4; ++t) { if (t < ntn) { const unsigned long long w = __hip_atomic_load(slot + t, __ATOMIC_RELAXED, __HIP_MEMORY_SCOPE_AGENT); mt[t] = __uint_as_float((unsigned)w); m2[t] = __uint_as_float((unsigned)(w >> 32)); } else { mt[t] = 0.f; m2[t] = 0.f; } ms += mt[t]; }
            const float mean = ms / (float)ntn; float q = 0.f;
#pragma unroll
            for (int t = 0; t < 4; ++t) if (t < ntn) { const float dm = mt[t] - mean; q += m2[t] + 256.0f * dm * dm; }
            S[row] = (f32x2v){mean, 1.0f / sqrtf(q / (256.0f * (float)ntn) + eps)};
        }
        asm volatile("s_waitcnt lgkmcnt(0)" ::: "memory"); __builtin_amdgcn_s_barrier(); asm volatile("" ::: "memory");
        return bad;
    }
};
struct EpiLnRes {
    static constexpr bool PERM = false, AFTER_DRAIN = true;
    const float* base; float* out; int ldc; const float* bias; PanelStats st; unsigned poison;
    __device__ __forceinline__ void fused(f32x4 (&acc)[2][2][4][2], const Unit& u, int wr, int wc, int fr, int fq, PG8_LAS unsigned char* lds, int wid, int lane) const {
        typedef float f32x2v __attribute__((ext_vector_type(2)));
        const PG8_LAS f32x2v* S = (const PG8_LAS f32x2v*)(lds + 8192);
        const int col0 = u.pn * BM + wc * 32 + 4 * fq;
#pragma unroll
        for (int bj = 0; bj < 2; ++bj)
#pragma unroll
            for (int n = 0; n < 2; ++n) { const f32x4 bv = bias ? *(const f32x4*)(bias + col0 + bj * HALF + n * 16) : (f32x4){0.f, 0.f, 0.f, 0.f};
#pragma unroll
                for (int ai = 0; ai < 2; ++ai)
#pragma unroll
                    for (int m = 0; m < 4; ++m) acc[ai][bj][m][n] += bv; }
        f32x4 pre[4][2][2];
#pragma unroll
        for (int m = 0; m < 4; ++m) { const size_t off = (size_t)(u.pm * BM + wr * 64 + m * 16 + fr) * ldc + col0;
#pragma unroll
            for (int bj = 0; bj < 2; ++bj)
#pragma unroll
                for (int n = 0; n < 2; ++n) pre[m][bj][n] = *(const f32x4*)(base + off + bj * HALF + n * 16); }
        const bool bad = st.run(acc, u, wr, wc, fr, fq, lds, wid, lane) || poison != 0u;
        const float qnan = __builtin_nanf("");
#pragma unroll
        for (int ai = 0; ai < 2; ++ai)
#pragma unroll
            for (int m = 0; m < 4; ++m) { const int r = ai * HALF + wr * 64 + m * 16 + fr; const f32x2v sr = S[r]; const size_t off = (size_t)(u.pm * BM + r) * ldc + col0;
#pragma unroll
                for (int bj = 0; bj < 2; ++bj)
#pragma unroll
                    for (int n = 0; n < 2; ++n) { const f32x4 bs = ai == 0 ? pre[m][bj][n] : *(const f32x4*)(base + off + bj * HALF + n * 16); f32x4 o = bs + (acc[ai][bj][m][n] - sr.x) * sr.y;
                        if (bad) o = (f32x4){qnan, qnan, qnan, qnan}; *(f32x4*)(out + off + bj * HALF + n * 16) = o; }
                if (m & 1) asm volatile("" ::: "memory"); }
    }
};
struct EpiLnResLn {
    static constexpr bool PERM = false, AFTER_DRAIN = true;
    const float* base; float* out; bf16_t* xn; int ldc; const float* bias; PanelStats st1, st2; unsigned poison;
    __device__ __forceinline__ void fused(f32x4 (&acc)[2][2][4][2], const Unit& u, int wr, int wc, int fr, int fq, PG8_LAS unsigned char* lds, int wid, int lane) const {
        typedef float f32x2v __attribute__((ext_vector_type(2))); typedef unsigned u32x2v __attribute__((ext_vector_type(2)));
        const PG8_LAS f32x2v* S = (const PG8_LAS f32x2v*)(lds + 8192);
        const int col0 = u.pn * BM + wc * 32 + 4 * fq;
#pragma unroll
        for (int bj = 0; bj < 2; ++bj)
#pragma unroll
            for (int n = 0; n < 2; ++n) { const f32x4 bv = bias ? *(const f32x4*)(bias + col0 + bj * HALF + n * 16) : (f32x4){0.f, 0.f, 0.f, 0.f};
#pragma unroll
                for (int ai = 0; ai < 2; ++ai)
#pragma unroll
                    for (int m = 0; m < 4; ++m) acc[ai][bj][m][n] += bv; }
        bool bad = st1.run(acc, u, wr, wc, fr, fq, lds, wid, lane) || poison != 0u;
        const float qnan = __builtin_nanf("");
#pragma unroll
        for (int ai = 0; ai < 2; ++ai)
#pragma unroll
            for (int m = 0; m < 4; ++m) { const int r = ai * HALF + wr * 64 + m * 16 + fr; const f32x2v sr = S[r]; const size_t off = (size_t)(u.pm * BM + r) * ldc + col0;
#pragma unroll
                for (int bj = 0; bj < 2; ++bj)
#pragma unroll
                    for (int n = 0; n < 2; ++n) { const f32x4 bs = *(const f32x4*)(base + off + bj * HALF + n * 16); acc[ai][bj][m][n] = bs + (acc[ai][bj][m][n] - sr.x) * sr.y; }
                asm volatile("" : "+v"(acc[ai][0][m][0]), "+v"(acc[ai][0][m][1]), "+v"(acc[ai][1][m][0]), "+v"(acc[ai][1][m][1]));
                if (m & 1) asm volatile("" ::: "memory"); }
        const bool bad1 = bad;
        bad = st2.run(acc, u, wr, wc, fr, fq, lds, wid, lane) || bad;
#pragma unroll
        for (int ai = 0; ai < 2; ++ai)
#pragma unroll
            for (int m = 0; m < 4; ++m) { const int r = ai * HALF + wr * 64 + m * 16 + fr; const f32x2v sr = S[r]; const size_t off = (size_t)(u.pm * BM + r) * ldc + col0;
#pragma unroll
                for (int bj = 0; bj < 2; ++bj)
#pragma unroll
                    for (int n = 0; n < 2; ++n) { const f32x4 x1 = acc[ai][bj][m][n]; *(f32x4*)(out + off + bj * HALF + n * 16) = bad1 ? (f32x4){qnan, qnan, qnan, qnan} : x1;
                        const f32x4 o = (x1 - sr.x) * sr.y; u32x2v w; w.x = cvt_pk_bf16(o[0], o[1]); w.y = cvt_pk_bf16(o[2], o[3]);
                        if (bad) { w.x = 0x7fc07fc0u; w.y = 0x7fc07fc0u; } *(u32x2v*)(xn + off + bj * HALF + n * 16) = w; }
                asm volatile("" ::: "memory"); }
    }
};

template <class Epi, class Sched, bool ALIGN_EPI = false, bool SP2 = false>
__device__ __forceinline__ void gemm_phase(PG8_LAS unsigned char* lds, const Gemm g, const Sched& S, const Epi& E) {
    int tid = threadIdx.x; asm volatile("" : "+v"(tid)); const int wid = __builtin_amdgcn_readfirstlane(tid >> 6), lane = tid & 63, wr = wid >> 2, wc = wid & 3, fr = lane & 15, fq = lane >> 4;
    const int K = g.K, nt = K / BK;
    unsigned voffA[2], voffB[2];
#pragma unroll
    for (int i = 0; i < 2; ++i) { int R, C; stage_rc(tid * 16 + i * 8192, R, C); const int Rb = Epi::PERM ? ((R & ~31) + perm32(R & 31)) : R;
        voffA[i] = (unsigned)(R * K + C) * 2u; voffB[i] = (unsigned)(Rb * K + C) * 2u; }
    const size_t kstep = (size_t)(BK * 2);
    const size_t hstep = (size_t)HALF * K * 2;
    const size_t tstep = 2 * hstep;
    const unsigned ldsw = (unsigned)wid * 1024u;
    const int aoff = lds_byte(wr * 64 + fr, fq * 8), boff = lds_byte(wc * 32 + fr, fq * 8);
#define PG8_SA(b, h) (((b) * 2 + (h)) * HTB)
#define PG8_SB(b, h) ((4 + (b) * 2 + (h)) * HTB)
#define PG8_STAGE(bufoff, gbase, voff) do { _Pragma("unroll") for (int _i = 0; _i < 2; ++_i) \
        __builtin_amdgcn_global_load_lds((const unsigned*)((const char*)(gbase) + (voff)[_i]), (PG8_LAS unsigned*)(lds + (bufoff) + ldsw + _i * 8192), 16, 0, 0); } while (0)
#define PG8_LDA(dst, b, h) do { _Pragma("unroll") for (int m = 0; m < 4; ++m) _Pragma("unroll") for (int k = 0; k < 2; ++k) dst[m][k] = *(const PG8_LAS bf16x8*)(lds + PG8_SA(b, h) + aoff + m * 2048 + k * 1024); } while (0)
#define PG8_LDB(dst, b, h) do { _Pragma("unroll") for (int n = 0; n < 2; ++n) _Pragma("unroll") for (int k = 0; k < 2; ++k) dst[n][k] = *(const PG8_LAS bf16x8*)(lds + PG8_SB(b, h) + boff + n * 2048 + k * 1024); } while (0)
#define PG8_MMA(ai, bj, At, Bt) do { __builtin_amdgcn_s_setprio(1); _Pragma("unroll") for (int m = 0; m < 4; ++m) _Pragma("unroll") for (int n = 0; n < 2; ++n) _Pragma("unroll") for (int k = 0; k < 2; ++k) \
        acc[ai][bj][m][n] = __builtin_amdgcn_mfma_f32_16x16x32_bf16(Bt[n][k], At[m][k], acc[ai][bj][m][n], 0, 0, 0); __builtin_amdgcn_s_setprio(0); } while (0)
#define PG8_WAIT_V(n) asm volatile("s_waitcnt vmcnt(" #n ")" ::: "memory")
#define PG8_WAIT_L(n) asm volatile("s_waitcnt lgkmcnt(" #n ")" ::: "memory")
#define PG8_BAR __builtin_amdgcn_s_barrier()
#define PG8_SCHED __builtin_amdgcn_sched_barrier(0)
    Unit cur, nxt; int ui = 0;
    if (!S.next(0, cur)) return;
    f32x4 acc[2][2][4][2];
#pragma unroll
    for (int a = 0; a < 2; ++a)
#pragma unroll
        for (int b = 0; b < 2; ++b)
#pragma unroll
            for (int m = 0; m < 4; ++m)
#pragma unroll
                for (int n = 0; n < 2; ++n) acc[a][b][m][n] = (f32x4){0.f, 0.f, 0.f, 0.f};
    bf16x8 At[4][2], B0[2][2], B1[2][2];
    const char* cA = (const char*)g.A + (size_t)cur.pm * tstep; const char* cB = (const char*)g.Bt + (size_t)cur.pn * tstep;
    S.a_ready(cur);
    if constexpr (SP2) {
        PG8_STAGE(PG8_SB(0, 0), cB, voffB); PG8_STAGE(PG8_SB(0, 1), cB + hstep, voffB); PG8_STAGE(PG8_SA(0, 0), cA, voffA); PG8_STAGE(PG8_SA(0, 1), cA + hstep, voffA);
        if (wr == 1) PG8_BAR;
        PG8_WAIT_V(2); PG8_BAR;
        PG8_STAGE(PG8_SB(1, 0), cB + kstep, voffB); PG8_STAGE(PG8_SA(1, 0), cA + kstep, voffA); PG8_STAGE(PG8_SB(1, 1), cB + hstep + kstep, voffB);
        PG8_WAIT_V(6); PG8_BAR;
    } else {
        PG8_STAGE(PG8_SB(0, 0), cB, voffB); PG8_STAGE(PG8_SA(0, 0), cA, voffA); PG8_STAGE(PG8_SB(0, 1), cB + hstep, voffB); PG8_STAGE(PG8_SA(0, 1), cA + hstep, voffA);
        if (wr == 1) PG8_BAR;
        PG8_WAIT_V(4); PG8_BAR;
        PG8_STAGE(PG8_SB(1, 0), cB + kstep, voffB); PG8_STAGE(PG8_SA(1, 0), cA + kstep, voffA); PG8_STAGE(PG8_SB(1, 1), cB + hstep + kstep, voffB);
        PG8_WAIT_V(6); PG8_BAR;
    }
    for (;;) {
        const bool has_next = S.next(ui + 1, nxt);
        const char* nA = has_next ? (const char*)g.A + (size_t)nxt.pm * tstep : cA; const char* nB = has_next ? (const char*)g.Bt + (size_t)nxt.pn * tstep : cB;
        for (int t = 0; t < nt; t += 2) {
            const bool last = (t == nt - 2);
            const char* a1 = cA + (size_t)(t + 1) * kstep;
            const char* a2 = last ? nA : cA + (size_t)(t + 2) * kstep; const char* b2 = last ? nB : cB + (size_t)(t + 2) * kstep;
            const char* a3 = a2 + kstep; const char* b3 = b2 + kstep;
            if (last && has_next) S.a_ready(nxt);
            if constexpr (SP2) {
            PG8_LDB(B0, 0, 0); PG8_LDB(B1, 0, 1); PG8_SCHED; PG8_LDA(At, 0, 0); PG8_STAGE(PG8_SA(1, 1), a1 + hstep, voffA);
            PG8_WAIT_V(8); PG8_WAIT_L(0); PG8_BAR; PG8_MMA(0, 0, At, B0); PG8_MMA(0, 1, At, B1); PG8_BAR; PG8_SCHED;
            PG8_LDA(At, 0, 1); PG8_STAGE(PG8_SB(0, 0), b2, voffB); PG8_STAGE(PG8_SB(0, 1), b2 + hstep, voffB); PG8_STAGE(PG8_SA(0, 0), a2, voffA);
            PG8_WAIT_V(8); PG8_WAIT_L(0); PG8_BAR; PG8_MMA(1, 0, At, B0); PG8_MMA(1, 1, At, B1); PG8_BAR; PG8_SCHED;
            PG8_LDB(B0, 1, 0); PG8_LDB(B1, 1, 1); PG8_SCHED; PG8_LDA(At, 1, 0); PG8_STAGE(PG8_SA(0, 1), a2 + hstep, voffA);
            PG8_WAIT_V(8); PG8_WAIT_L(0); PG8_BAR; PG8_MMA(0, 0, At, B0); PG8_MMA(0, 1, At, B1); PG8_BAR; PG8_SCHED;
            PG8_LDA(At, 1, 1); PG8_STAGE(PG8_SB(1, 0), b3, voffB); PG8_STAGE(PG8_SB(1, 1), b3 + hstep, voffB); PG8_STAGE(PG8_SA(1, 0), a3, voffA);
            PG8_WAIT_V(8); PG8_WAIT_L(0); PG8_BAR; PG8_MMA(1, 0, At, B0); PG8_MMA(1, 1, At, B1); PG8_BAR; PG8_SCHED;
            } else {
            PG8_LDB(B0, 0, 0); PG8_SCHED; PG8_LDA(At, 0, 0); PG8_STAGE(PG8_SA(1, 1), a1 + hstep, voffA);
            PG8_WAIT_L(8); PG8_BAR; PG8_WAIT_L(0); PG8_MMA(0, 0, At, B0); PG8_BAR; PG8_SCHED;
            PG8_LDB(B1, 0, 1); PG8_STAGE(PG8_SB(0, 0), b2, voffB);
            PG8_BAR; PG8_WAIT_L(0); PG8_MMA(0, 1, At, B1); PG8_BAR;
            PG8_LDA(At, 0, 1); PG8_STAGE(PG8_SA(0, 0), a2, voffA);
            PG8_BAR; PG8_WAIT_L(0); PG8_MMA(1, 0, At, B0); PG8_BAR; PG8_SCHED;
            PG8_STAGE(PG8_SB(0, 1), b2 + hstep, voffB);
            PG8_WAIT_V(6); PG8_BAR; PG8_MMA(1, 1, At, B1); PG8_BAR;
            PG8_LDB(B0, 1, 0); PG8_SCHED; PG8_LDA(At, 1, 0); PG8_STAGE(PG8_SA(0, 1), a2 + hstep, voffA);
            PG8_WAIT_L(8); PG8_BAR; PG8_WAIT_L(0); PG8_MMA(0, 0, At, B0); PG8_BAR; PG8_SCHED;
            PG8_LDB(B1, 1, 1); PG8_STAGE(PG8_SB(1, 0), b3, voffB);
            PG8_BAR; PG8_WAIT_L(0); PG8_MMA(0, 1, At, B1); PG8_BAR;
            PG8_LDA(At, 1, 1); PG8_STAGE(PG8_SA(1, 0), a3, voffA);
            PG8_BAR; PG8_WAIT_L(0); PG8_MMA(1, 0, At, B0); PG8_BAR; PG8_SCHED;
            PG8_STAGE(PG8_SB(1, 1), b3 + hstep, voffB);
            PG8_WAIT_V(6); PG8_BAR; PG8_MMA(1, 1, At, B1); PG8_BAR;
            }
        }
        if constexpr (ALIGN_EPI) { if (wr == 0) PG8_BAR; }
        if constexpr (!Epi::AFTER_DRAIN) { E(acc, cur, wr, wc, fr, fq); S.done(cur); }
        if (!has_next) break;
#pragma unroll
        for (int a = 0; a < 2; ++a)
#pragma unroll
            for (int b = 0; b < 2; ++b)
#pragma unroll
                for (int m = 0; m < 4; ++m)
#pragma unroll
                    for (int n = 0; n < 2; ++n) acc[a][b][m][n] = (f32x4){0.f, 0.f, 0.f, 0.f};
        cur = nxt; cA = nA; cB = nB; ++ui;
        if constexpr (ALIGN_EPI) { if (wr == 1) PG8_BAR; }
    }
    PG8_WAIT_V(0);
    if constexpr (!ALIGN_EPI) { if (wr == 0) PG8_BAR; }
    PG8_BAR;
    if constexpr (Epi::AFTER_DRAIN) { E.fused(acc, cur, wr, wc, fr, fq, lds, wid, lane); S.done(cur); }
#undef PG8_SA
#undef PG8_SB
#undef PG8_STAGE
#undef PG8_LDA
#undef PG8_LDB
#undef PG8_MMA
#undef PG8_WAIT_V
#undef PG8_WAIT_L
#undef PG8_BAR
#undef PG8_SCHED
}
}
#define GAS __attribute__((address_space(1)))
#define LAS __attribute__((address_space(3)))
#define DI __device__ __forceinline__
typedef unsigned short bf16;
typedef unsigned v4u __attribute__((ext_vector_type(4)));
typedef unsigned v2u __attribute__((ext_vector_type(2)));
typedef float f32x4 __attribute__((ext_vector_type(4)));
typedef float f32x16 __attribute__((ext_vector_type(16)));
typedef short bf16x8 __attribute__((ext_vector_type(8)));
typedef short s16x4 __attribute__((ext_vector_type(4)));
#define LDS_WAIT() asm volatile("s_waitcnt lgkmcnt(0)" ::: "memory")

constexpr int DM = 1024, NB = 16, SEQ = 4096, NTOK = NB * SEQ, DEPTH = 4, HD = 128, DINNER = 2048, MEMH = 4, MEML = 256, MIXH = 12;
constexpr int NCHUNK = 4, CB = NB / NCHUNK, CM = CB * SEQ;
constexpr int N_A = 5120, N_B = 10240, N_C = 7168;
constexpr float LN_EPS = 1e-5f;
constexpr float ALPHA = 1.6817928305074290f;
constexpr float LOG2E = 1.4426950408889634f;
constexpr float QSCALE = 0.08838834764831845f * LOG2E;
constexpr int NWAVES = 8, NTHR = 512;

constexpr size_t MiB = 1u << 20;
constexpr size_t WS_ROPE = 1 * MiB;
constexpr size_t WS_WIN = 2 * MiB;
constexpr size_t WS_WMKV = 56 * MiB;
constexpr size_t WS_WOUT = 64 * MiB;
constexpr size_t WS_MEMB = 80 * MiB;
constexpr size_t WS_MKV = 88 * MiB;
constexpr size_t WS_XN = 120 * MiB;
constexpr size_t WS_PROJ = 248 * MiB;
constexpr size_t WS_Y = 568 * MiB;
constexpr size_t WS_LSE = 632 * MiB;
constexpr size_t WS_END = 636 * MiB;

struct Args {
    const float* x; const float* mem; const float* w_in_a; const float* sink_a; const float* w_in_b; const float* w_in_c; const float* rpb_c;
    const float* w_mkv; const float* w_out; const float* ln_g; const float* ln_b; float* out; unsigned char* ws;
};

DI unsigned f2bf(float f) { unsigned u = __builtin_bit_cast(unsigned, f); return (u + 0x7fffu + ((u >> 16) & 1u)) >> 16; }
DI unsigned pk2(float lo, float hi) { return f2bf(lo) | (f2bf(hi) << 16); }
DI float bf_lo(unsigned u) { return __builtin_bit_cast(float, u << 16); }
DI float bf_hi(unsigned u) { return __builtin_bit_cast(float, u & 0xffff0000u); }
typedef float f32x2_t __attribute__((ext_vector_type(2))); typedef __bf16 bf16x2_t __attribute__((ext_vector_type(2)));
DI unsigned cvtpk(float lo, float hi) { f32x2_t v = {lo, hi}; bf16x2_t b = __builtin_convertvector(v, bf16x2_t); return __builtin_bit_cast(unsigned, b); }
DI float silu(float x) { return x / (1.f + __expf(-x)); }

struct EpiProj {
    static constexpr bool PERM = true, AFTER_DRAIN = false;
    bf16* O; int ldc; int rope_end; int q_end; int mq_off; const float* rope;
    DI void operator()(const pg8::f32x4 (&acc)[2][2][4][2], const pg8::Unit& u, int wr, int wc, int fr, int fq) const {
        const int colt = u.pn * 256;
        const bool do_rope = (colt < rope_end) && (wc == 0);
        const float sc = (colt < q_end || (colt >= mq_off && colt < mq_off + 512)) ? QSCALE : 1.f;
        const int row0 = u.pm * 256 + wr * 64 + fr, col0 = colt + wc * 32 + 8 * fq;
#pragma unroll
        for (int ai = 0; ai < 2; ++ai)
#pragma unroll
            for (int m = 0; m < 4; ++m) {
                const int row = row0 + ai * 128 + m * 16;
                bf16* rowp = O + (size_t)row * ldc + col0;
                f32x4 cs0 = {1.f, 0.f, 1.f, 0.f}, cs1 = cs0, cs2 = cs0, cs3 = cs0;
                if (do_rope) { const f32x4* rp = (const f32x4*)(rope + ((size_t)(row & (SEQ - 1)) * 16 + 8 * (fq & 1)) * 2);
                    cs0 = rp[0]; cs1 = rp[1]; cs2 = rp[2]; cs3 = rp[3]; }
#pragma unroll
                for (int bj = 0; bj < 2; ++bj) {
                    f32x4 v0 = acc[ai][bj][m][0], v1 = acc[ai][bj][m][1];
                    if (do_rope) {
                        f32x4 p0, p1;
#pragma unroll
                        for (int e = 0; e < 4; ++e) { p0[e] = __shfl_xor(v0[e], 32); p1[e] = __shfl_xor(v1[e], 32); }
                        const float sg = (fq < 2) ? -1.f : 1.f;
                        v0[0] = v0[0] * cs0[0] + sg * p0[0] * cs0[1]; v0[1] = v0[1] * cs0[2] + sg * p0[1] * cs0[3];
                        v0[2] = v0[2] * cs1[0] + sg * p0[2] * cs1[1]; v0[3] = v0[3] * cs1[2] + sg * p0[3] * cs1[3];
                        v1[0] = v1[0] * cs2[0] + sg * p1[0] * cs2[1]; v1[1] = v1[1] * cs2[2] + sg * p1[1] * cs2[3];
                        v1[2] = v1[2] * cs3[0] + sg * p1[2] * cs3[1]; v1[3] = v1[3] * cs3[2] + sg * p1[3] * cs3[3];
                    }
                    v0 = v0 * sc; v1 = v1 * sc;
                    pg8::u32x4 w; w.x = pg8::cvt_pk_bf16(v0[0], v0[1]); w.y = pg8::cvt_pk_bf16(v0[2], v0[3]); w.z = pg8::cvt_pk_bf16(v1[0], v1[1]); w.w = pg8::cvt_pk_bf16(v1[2], v1[3]);
                    *(pg8::u32x4*)(rowp + bj * 128) = w;
                }
            }
    }
};
struct EpiResid {
    static constexpr bool PERM = false, AFTER_DRAIN = false;
    const float* xin; float* zout;
    DI void operator()(const pg8::f32x4 (&acc)[2][2][4][2], const pg8::Unit& u, int wr, int wc, int fr, int fq) const {
        const int col0 = u.pn * 256 + wc * 32 + 4 * fq;
#pragma unroll
        for (int ai = 0; ai < 2; ++ai)
#pragma unroll
            for (int m = 0; m < 4; ++m) {
                const size_t off = (size_t)(u.pm * 256 + ai * 128 + wr * 64 + m * 16 + fr) * DM + col0;
#pragma unroll
                for (int bj = 0; bj < 2; ++bj)
#pragma unroll
                    for (int n = 0; n < 2; ++n) { const f32x4 b = *(const f32x4*)(xin + off + bj * 128 + n * 16);
                        *(f32x4*)(zout + off + bj * 128 + n * 16) = b * ALPHA + acc[ai][bj][m][n]; }
                asm volatile("" ::: "memory");
            }
    }
};

DI float wave_sum(float v) {
#pragma unroll
    for (int o = 1; o < 64; o <<= 1) v += __shfl_xor(v, o);
    return v;
}
DI void p0_transpose_item(const float* W, int K, int N, bf16* WT, int row_off, LAS float* scr, int item, int lane) {
    const int nblk = N / 32, kb = item / nblk, nb = item % nblk, k0 = 64 * kb, n0 = 32 * nb;
#pragma unroll 8
    for (int i = 0; i < 32; ++i) { const int kk = 2 * i + (lane >> 5); scr[kk * 33 + (lane & 31)] = W[(size_t)(k0 + kk) * N + n0 + (lane & 31)]; }
    LDS_WAIT(); asm volatile("" ::: "memory");
    const int c = lane & 7;
#pragma unroll
    for (int j = 0; j < 4; ++j) { const int n = (lane >> 3) + 8 * j; const LAS float* s = scr + (8 * c) * 33 + n;
        v4u o; o.x = pk2(s[0 * 33], s[1 * 33]); o.y = pk2(s[2 * 33], s[3 * 33]); o.z = pk2(s[4 * 33], s[5 * 33]); o.w = pk2(s[6 * 33], s[7 * 33]);
        *(v4u*)(WT + (size_t)(row_off + n0 + n) * K + k0 + 8 * c) = o; }
    LDS_WAIT(); asm volatile("" ::: "memory");
}
DI void cvt_rows(const float* src, bf16* dst, size_t n8, size_t gtid, size_t gn) {
    for (size_t i = gtid; i < n8; i += gn) {
        const f32x4 a = *(const f32x4*)(src + i * 8), b = *(const f32x4*)(src + i * 8 + 4);
        v4u o; o.x = cvtpk(a[0], a[1]); o.y = cvtpk(a[2], a[3]); o.z = cvtpk(b[0], b[1]); o.w = cvtpk(b[2], b[3]);
        *(v4u*)(dst + i * 8) = o;
    }
}

constexpr int KROWB = 272, VOFF = 64 * KROWB, VBLK = 64 * 64, BOFF = VOFF + 4 * VBLK, ATT_LDS = BOFF + 2048;
typedef const LAS char* ldsc;
typedef short v4i16_t __attribute__((ext_vector_type(4)));
DI s16x4 vtr(ldsc p) { return __builtin_bit_cast(s16x4, __builtin_amdgcn_ds_read_tr16_b64_v4i16((LAS v4i16_t*)p)); }
#define MFMA32(a, b, c) __builtin_amdgcn_mfma_f32_32x32x16_bf16((a), (b), (c), 0, 0, 0)
DI int crow0(int r) { return (r & 3) + 8 * (r >> 2); }

struct BandMask { int base, w; unsigned w2; ldsc bias;
    DI float operator()(int r, float s) const { const int d = base + crow0(r); return ((unsigned)(d + w) <= w2) ? s : -INFINITY; } };
struct NbrMask { bool rowvalid; int kc0, cs, bidx; const LAS float* bias;
    DI float operator()(int r, float s) const { const int kc = kc0 + crow0(r); const bool v = rowvalid && ((unsigned)(kc - cs) < 16u);
        const float b = bias[v ? (bidx + kc) : 0]; return v ? (s + b) : -INFINITY; } };

template <class MF>
DI void att_subtile(ldsc kp, ldsc vp, const bf16x8 (&qf)[8], f32x16 (&o)[4], float& m, float& l, const MF& mf) {
    f32x16 s;
#pragma unroll
    for (int i = 0; i < 16; ++i) s[i] = 0.f;
#pragma unroll
    for (int kk = 0; kk < 8; ++kk) { const bf16x8 kf = *(const LAS bf16x8*)(kp + kk * 32); s = MFMA32(kf, qf[kk], s); }
    float mt = -INFINITY;
#pragma unroll
    for (int r = 0; r < 16; ++r) { s[r] = mf(r, s[r]); mt = fmaxf(mt, s[r]); }
    mt = fmaxf(mt, __shfl_xor(mt, 32));
    const float mn = fmaxf(m, mt);
    const float alpha = __builtin_amdgcn_exp2f(m - mn); m = mn;
    float ps = 0.f;
#pragma unroll
    for (int r = 0; r < 16; ++r) { s[r] = __builtin_amdgcn_exp2f(s[r] - mn); ps += s[r]; }
    l = l * alpha + ps;
#pragma unroll
    for (int d = 0; d < 4; ++d) o[d] = o[d] * alpha;
    v4u pa, pb;
    pa.x = cvtpk(s[0], s[1]); pa.y = cvtpk(s[2], s[3]); pa.z = cvtpk(s[4], s[5]); pa.w = cvtpk(s[6], s[7]);
    pb.x = cvtpk(s[8], s[9]); pb.y = cvtpk(s[10], s[11]); pb.z = cvtpk(s[12], s[13]); pb.w = cvtpk(s[14], s[15]);
    const bf16x8 pf0 = __builtin_bit_cast(bf16x8, pa), pf1 = __builtin_bit_cast(bf16x8, pb);
#pragma unroll
    for (int d = 0; d < 4; ++d) {
        const s16x4 lo0 = vtr(vp + d * VBLK), hi0 = vtr(vp + d * VBLK + 8 * 64), lo1 = vtr(vp + d * VBLK + 16 * 64), hi1 = vtr(vp + d * VBLK + 24 * 64);
        const bf16x8 v0 = __builtin_shufflevector(lo0, hi0, 0, 1, 2, 3, 4, 5, 6, 7), v1 = __builtin_shufflevector(lo1, hi1, 0, 1, 2, 3, 4, 5, 6, 7);
        o[d] = MFMA32(v0, pf0, o[d]); o[d] = MFMA32(v1, pf1, o[d]);
    }
}

struct KVRegs { v4u k0, k1, v0, v1; };
DI void kv_prefetch(KVRegs& R, const bf16* Kp, const bf16* Vp, size_t rs, int tid) {
    const size_t o0 = (size_t)(tid >> 4) * rs + (tid & 15) * 8, o1 = o0 + 32 * rs;
    R.k0 = *(const v4u*)(Kp + o0); R.k1 = *(const v4u*)(Kp + o1); R.v0 = *(const v4u*)(Vp + o0); R.v1 = *(const v4u*)(Vp + o1);
}
DI void kv_store(const KVRegs& R, LAS unsigned char* lds, int tid) {
    const int row = tid >> 4, c = tid & 15;
    *(LAS v4u*)(lds + row * KROWB + c * 16) = R.k0; *(LAS v4u*)(lds + (row + 32) * KROWB + c * 16) = R.k1;
    LAS unsigned char* vb = lds + VOFF + (c >> 2) * VBLK + (c & 3) * 16;
    *(LAS v4u*)(vb + row * 64) = R.v0; *(LAS v4u*)(vb + (row + 32) * 64) = R.v1;
}

DI void att_finish(const f32x16 (&o)[4], float m, float l, int lane, int mode, const bf16* gate_row, bf16* out_row, float* lse_p) {
    const int h = lane >> 5;
    const float lt = l + __shfl_xor(l, 32), inv = 1.f / lt;
    if (mode == 1 && h == 0) *lse_p = m + __builtin_amdgcn_logf(lt);
#pragma unroll
    for (int d = 0; d < 4; ++d)
#pragma unroll
        for (int g = 0; g < 4; ++g) {
            const int dd = 32 * d + 8 * g + 4 * h;
            float a0 = o[d][4 * g] * inv, a1 = o[d][4 * g + 1] * inv, a2 = o[d][4 * g + 2] * inv, a3 = o[d][4 * g + 3] * inv;
            if (mode == 0) { const v2u gt = *(const v2u*)(gate_row + dd);
                a0 *= silu(bf_lo(gt.x)); a1 *= silu(bf_hi(gt.x)); a2 *= silu(bf_lo(gt.y)); a3 *= silu(bf_hi(gt.y)); }
            v2u w; w.x = cvtpk(a0, a1); w.y = cvtpk(a2, a3);
            *(v2u*)(out_row + dd) = w;
        }
}

DI void band_unit(LAS unsigned char* lds, const bf16* Qp, size_t q_rs, const bf16* Kp, const bf16* Vp, size_t kv_rs, int Lk, int i0, int w,
                  float m_init, float l_init, int mode, const bf16* gate_p, size_t gate_rs, bf16* out_p, size_t out_rs, float* lse_p, size_t lse_rs) {
    int tid = threadIdx.x; asm volatile("" : "+v"(tid)); const int lane = tid & 63, wid = __builtin_amdgcn_readfirstlane(tid >> 6), h = lane >> 5, ql = lane & 31;
    const int qw0 = i0 + wid * 32, qi = qw0 + ql;
    bf16x8 qf[8];
    { const bf16* qrow = Qp + (size_t)qi * q_rs + 8 * h;
#pragma unroll
      for (int kk = 0; kk < 8; ++kk) qf[kk] = *(const bf16x8*)(qrow + 16 * kk); }
    int jlo = i0 - w; if (jlo < 0) jlo = 0; jlo &= ~63;
    int jhi = i0 + 255 + w; if (jhi > Lk - 1) jhi = Lk - 1;
    const int nt = (jhi >> 6) - (jlo >> 6) + 1;
    f32x16 o[4];
#pragma unroll
    for (int d = 0; d < 4; ++d)
#pragma unroll
        for (int i = 0; i < 16; ++i) o[d][i] = 0.f;
    float m = m_init, l = (h == 0) ? l_init : 0.f;
    const ldsc kp = (ldsc)lds + ql * KROWB + h * 16;
    const ldsc vp = (ldsc)lds + VOFF + (4 * h + ((lane & 15) >> 2)) * 64 + 8 * (4 * ((lane >> 4) & 1) + (lane & 3));
    KVRegs R;
    kv_prefetch(R, Kp + (size_t)jlo * kv_rs, Vp + (size_t)jlo * kv_rs, kv_rs, tid);
    for (int t = 0; t < nt; ++t) {
        const int j0 = jlo + 64 * t;
        __syncthreads();
        kv_store(R, lds, tid);
        __syncthreads();
        if (t + 1 < nt) kv_prefetch(R, Kp + (size_t)(j0 + 64) * kv_rs, Vp + (size_t)(j0 + 64) * kv_rs, kv_rs, tid);
#pragma unroll
        for (int sub = 0; sub < 2; ++sub) {
            const int js = j0 + 32 * sub;
            if (js + 31 < qw0 - w || js > qw0 + 31 + w) continue;
            const BandMask mf{js + 4 * h - qi, w, 2u * (unsigned)w, nullptr};
            att_subtile(kp + sub * 32 * KROWB, vp + sub * 32 * 64, qf, o, m, l, mf);
        }
    }
    att_finish(o, m, l, lane, mode, gate_p + (size_t)qi * gate_rs, out_p + (size_t)qi * out_rs, lse_p + (size_t)qi * lse_rs);
}

DI void nbr_unit(LAS unsigned char* lds, const bf16* Qp, const bf16* Kp, const bf16* Vp, size_t rs, const float* rpb_h, int R,
                 const bf16* gate_p, bf16* y_p) {
    int tid = threadIdx.x; asm volatile("" : "+v"(tid)); const int lane = tid & 63, wid = __builtin_amdgcn_readfirstlane(tid >> 6), h = lane >> 5, ql = lane & 31;
    const int qr = 4 * R + (ql >> 3), qc = 8 * wid + (ql & 7), tok = qr * 64 + qc;
    int rs_ = qr - 4; rs_ = rs_ < 0 ? 0 : (rs_ > 56 ? 56 : rs_);
    int cs_ = qc - 8; cs_ = cs_ < 0 ? 0 : (cs_ > 48 ? 48 : cs_);
    int c0 = 8 * wid - 8; c0 = c0 < 0 ? 0 : (c0 > 32 ? 32 : c0);
    int kr_lo = 4 * R - 4; kr_lo = kr_lo < 0 ? 0 : (kr_lo > 56 ? 56 : kr_lo);
    int kr_hi = 4 * R - 1; kr_hi = (kr_hi < 0 ? 0 : (kr_hi > 56 ? 56 : kr_hi)) + 7;
    const int nt = kr_hi - kr_lo + 1;
    bf16x8 qf[8];
    { const bf16* qrow = Qp + (size_t)tok * rs + 8 * h;
#pragma unroll
      for (int kk = 0; kk < 8; ++kk) qf[kk] = *(const bf16x8*)(qrow + 16 * kk); }
    LAS float* bias = (LAS float*)(lds + BOFF);
    __syncthreads();
    if (tid < 465) bias[tid] = rpb_h[tid] * LOG2E;
    f32x16 o[4];
#pragma unroll
    for (int d = 0; d < 4; ++d)
#pragma unroll
        for (int i = 0; i < 16; ++i) o[d][i] = 0.f;
    float m = -1e30f, l = 0.f;
    const ldsc kp = (ldsc)lds + (c0 + ql) * KROWB + h * 16;
    const ldsc vp = (ldsc)lds + VOFF + (c0 + 4 * h + ((lane & 15) >> 2)) * 64 + 8 * (4 * ((lane >> 4) & 1) + (lane & 3));
    KVRegs Rg;
    kv_prefetch(Rg, Kp + (size_t)(kr_lo * 64) * rs, Vp + (size_t)(kr_lo * 64) * rs, rs, tid);
    for (int t = 0; t < nt; ++t) {
        const int kr = kr_lo + t;
        __syncthreads();
        kv_store(Rg, lds, tid);
        __syncthreads();
        if (t + 1 < nt) kv_prefetch(Rg, Kp + (size_t)((kr + 1) * 64) * rs, Vp + (size_t)((kr + 1) * 64) * rs, rs, tid);
        const NbrMask mf{(unsigned)(kr - rs_) < 8u, c0 + 4 * h, cs_, (kr - qr + 7) * 31 + 15 - qc, bias};
        att_subtile(kp, vp, qf, o, m, l, mf);
    }
    att_finish(o, m, l, lane, 0, gate_p + (size_t)tok * rs, y_p + (size_t)tok * DINNER, nullptr);
}

DI void ln_rows(const float* z, float* xo, bf16* xn, const float* g, const float* b, int nrows, int gw, int ngw, int lane) {
    f32x4 gv[4], bv[4];
#pragma unroll
    for (int j = 0; j < 4; ++j) { gv[j] = *((const f32x4*)g + lane + 64 * j); bv[j] = *((const f32x4*)b + lane + 64 * j); }
    for (int r = gw; r < nrows; r += ngw) {
        const f32x4* zr = (const f32x4*)(z + (size_t)r * DM) + lane;
        f32x4 v[4]; float s = 0.f;
#pragma unroll
        for (int j = 0; j < 4; ++j) { v[j] = zr[64 * j]; s += (v[j][0] + v[j][1]) + (v[j][2] + v[j][3]); }
        const float mean = wave_sum(s) * (1.f / DM); float s2 = 0.f;
#pragma unroll
        for (int j = 0; j < 4; ++j) { v[j] = v[j] - mean; s2 += (v[j][0] * v[j][0] + v[j][1] * v[j][1]) + (v[j][2] * v[j][2] + v[j][3] * v[j][3]); }
        const float rstd = 1.f / sqrtf(wave_sum(s2) * (1.f / DM) + LN_EPS);
        f32x4* xr = (f32x4*)(xo + (size_t)r * DM) + lane;
        v2u* nr = (v2u*)(xn + (size_t)r * DM) + lane;
#pragma unroll
        for (int j = 0; j < 4; ++j) { const f32x4 y = v[j] * rstd * gv[j] + bv[j]; xr[64 * j] = y;
            v2u w; w.x = cvtpk(y[0], y[1]); w.y = cvtpk(y[2], y[3]); nr[64 * j] = w; }
    }
}
DI void combine_b(const bf16* proj, const float* lse, bf16* y, size_t gtid, size_t gn) {
    const size_t total = (size_t)CM * MIXH * 16;
    for (size_t i = gtid; i < total; i += gn) {
        const size_t row = i / 192; const int rem = (int)(i % 192), hh = rem >> 4, c = rem & 15;
        const float l0 = lse[row * 12 + hh], l1 = lse[(size_t)CM * 12 + row * 12 + hh], l2 = lse[(size_t)2 * CM * 12 + row * 12 + hh];
        const float mx = fmaxf(l0, fmaxf(l1, l2));
        float w0 = __builtin_amdgcn_exp2f(l0 - mx), w1 = __builtin_amdgcn_exp2f(l1 - mx), w2 = __builtin_amdgcn_exp2f(l2 - mx);
        const float inv = 1.f / (w0 + w1 + w2); w0 *= inv; w1 *= inv; w2 *= inv;
        const bf16* pr = proj + row * N_B + hh * 128 + c * 8;
        const v4u a = *(const v4u*)pr, b = *(const v4u*)(pr + 12 * 128), d = *(const v4u*)(pr + 24 * 128), gt = *(const v4u*)(pr + 8192);
        v4u o;
#pragma unroll
        for (int e = 0; e < 4; ++e) {
            const float lo = (w0 * bf_lo(a[e]) + w1 * bf_lo(b[e]) + w2 * bf_lo(d[e])) * silu(bf_lo(gt[e]));
            const float hi = (w0 * bf_hi(a[e]) + w1 * bf_hi(b[e]) + w2 * bf_hi(d[e])) * silu(bf_hi(gt[e]));
            o[e] = cvtpk(lo, hi);
        }
        *(v4u*)(y + row * DINNER + hh * 128 + c * 8) = o;
    }
}

constexpr int LDS_BYTES = 131072;
__global__ void __launch_bounds__(NTHR, 2) fwd_megakernel(Args a) {
    extern __shared__ __attribute__((aligned(16))) unsigned char lds_raw[];
    LAS unsigned char* lds = (LAS unsigned char*)lds_raw;
    cg::grid_group grid = cg::this_grid();
    const int G = gridDim.x, bx = blockIdx.x;
#define TID_VARS int tid = threadIdx.x; asm volatile("" : "+v"(tid)); const int lane = tid & 63, wave = __builtin_amdgcn_readfirstlane(tid >> 6); \
    const int gw = bx * NWAVES + wave, ngw = G * NWAVES; const size_t gtid = (size_t)bx * NTHR + tid, gn = (size_t)G * NTHR; (void)lane; (void)gw; (void)ngw; (void)gtid; (void)gn;
    unsigned char* ws = a.ws;
    float* rope = (float*)(ws + WS_ROPE);
    bf16* win_t = (bf16*)(ws + WS_WIN); bf16* wmkv_t = (bf16*)(ws + WS_WMKV); bf16* wout_t = (bf16*)(ws + WS_WOUT);
    bf16* memb = (bf16*)(ws + WS_MEMB); bf16* mkv = (bf16*)(ws + WS_MKV); bf16* xn = (bf16*)(ws + WS_XN);
    bf16* proj = (bf16*)(ws + WS_PROJ); bf16* ybuf = (bf16*)(ws + WS_Y); float* lse = (float*)(ws + WS_LSE);

    {
        TID_VARS
        LAS float* scr = (LAS float*)(lds + wave * 16384);
        constexpr int I_A = 16 * 160, I_B = 16 * 320, I_C = 16 * 224, I_M = 16 * 32, I_O = 32 * 32;
        constexpr int NIT = 2 * I_A + I_B + I_C + 4 * I_M + 4 * I_O;
        for (int it = gw; it < NIT; it += ngw) {
            int r = it;
            if (r < I_A) { p0_transpose_item(a.w_in_a, DM, N_A, win_t, 0, scr, r, lane); continue; } r -= I_A;
            if (r < I_B) { p0_transpose_item(a.w_in_b, DM, N_B, win_t + (size_t)N_A * DM, 0, scr, r, lane); continue; } r -= I_B;
            if (r < I_C) { p0_transpose_item(a.w_in_c, DM, N_C, win_t + (size_t)(N_A + N_B) * DM, 0, scr, r, lane); continue; } r -= I_C;
            if (r < I_A) { p0_transpose_item(a.w_in_a + (size_t)DM * N_A, DM, N_A, win_t + (size_t)(N_A + N_B + N_C) * DM, 0, scr, r, lane); continue; } r -= I_A;
            if (r < 4 * I_M) { const int li = r / I_M; p0_transpose_item(a.w_mkv + (size_t)li * DM * 1024, DM, 1024, wmkv_t, li * 1024, scr, r % I_M, lane); continue; } r -= 4 * I_M;
            { const int li = r / I_O; p0_transpose_item(a.w_out + (size_t)li * DINNER * DM, DINNER, DM, wout_t + (size_t)li * DM * DINNER, 0, scr, r % I_O, lane); }
        }
        for (size_t i = gtid; i < (size_t)SEQ * 16; i += gn) {
            const int pos = (int)(i >> 4), k = (int)(i & 15);
            const float inv = powf(500000.0f, -(float)k / 16.0f);
            const float ang = (float)pos * inv;
            rope[2 * i] = cosf(ang); rope[2 * i + 1] = sinf(ang);
        }
        cvt_rows(a.mem, memb, (size_t)NB * MEML * DM / 8, gtid, gn);
        cvt_rows(a.x, xn, (size_t)NTOK * DM / 8, gtid, gn);
    }
    grid.sync();
    {
        pg8::Gemm g{memb, wmkv_t, NB * MEML, 4 * 1024, DM}; pg8::StaticOrder S; S.init(NB * MEML, 4 * 1024, G, bx);
        EpiProj E{mkv, 4 * 1024, 0, 0, 1 << 30, rope};
        pg8::gemm_phase<EpiProj, pg8::StaticOrder, true, true>(lds, g, S, E);
    }
    for (int c = 0; c < NCHUNK; ++c) {
        for (int l = 0; l < DEPTH; ++l) {
            const int kind = (l == 3) ? 0 : l;
            const int N = kind == 0 ? N_A : (kind == 1 ? N_B : N_C);
            const size_t woff = (l == 0) ? 0 : (l == 1 ? (size_t)N_A : (l == 2 ? (size_t)(N_A + N_B) : (size_t)(N_A + N_B + N_C)));
            const int q_end = kind == 1 ? 4608 : 1536;
            const int rope_end = kind == 0 ? 2048 : (kind == 1 ? 6144 : 0);
            const int k_off = q_end, v_off = kind == 0 ? 2048 : (kind == 1 ? 6144 : 3072);
            const int mq_off = kind == 0 ? 2560 : (kind == 1 ? 7680 : 4608), gate_off = mq_off + 512;
            {
                pg8::Gemm g{xn + (size_t)c * CM * DM, win_t + woff * DM, CM, N, DM}; pg8::StaticOrder S; S.init(CM, N, G, bx);
                EpiProj E{proj, N, rope_end, q_end, mq_off, rope};
                pg8::gemm_phase<EpiProj, pg8::StaticOrder, true, true>(lds, g, S, E);
            }
            grid.sync();
            {
                const int nmix = kind == 1 ? CB * MIXH * 48 : CB * MIXH * 16, nmem = CB * MEMH * 16;
                for (int u = bx; u < nmix + nmem; u += G) {
                    if (u >= nmix) {
                        const int v = u - nmix, b = v >> 6, mh = (v >> 4) & 3, blk = v & 15;
                        const bf16* pb = proj + (size_t)b * SEQ * N;
                        const bf16* kp = mkv + (size_t)((c * CB + b) * MEML) * 4096 + l * 1024 + mh * 128;
                        band_unit(lds, pb + mq_off + mh * 128, N, kp, kp + 512, 4096, MEML, blk * 256, 1 << 20, -1e30f, 0.f, 0,
                                  pb + gate_off + (MIXH + mh) * 128, N, ybuf + (size_t)b * SEQ * DINNER + (MIXH + mh) * 128, DINNER, nullptr, 0);
                    } else if (kind == 0) {
                        const int b = u / 192, rem = u % 192, hh = rem >> 4, blk = rem & 15;
                        const bf16* pb = proj + (size_t)b * SEQ * N;
                        const float sk = a.sink_a[(l == 3 ? 12 : 0) + hh] * LOG2E;
                        band_unit(lds, pb + hh * 128, N, pb + k_off + (hh / 3) * 128, pb + v_off + (hh / 3) * 128, N, SEQ, blk * 256, 128, sk, 1.f, 0,
                                  pb + gate_off + hh * 128, N, ybuf + (size_t)b * SEQ * DINNER + hh * 128, DINNER, nullptr, 0);
                    } else if (kind == 1) {
                        const int b = u / 576, rem = u % 576, hh = rem / 48, rem2 = rem % 48, gi = rem2 >> 4, idx = rem2 & 15;
                        const int dil = 1 << (2 * gi), cls = idx & (dil - 1), blk = idx >> (2 * gi);
                        bf16* pb = proj + ((size_t)b * SEQ + cls) * N;
                        bf16* qp = pb + (gi * MIXH + hh) * 128;
                        band_unit(lds, qp, (size_t)dil * N, pb + k_off + hh * 128, pb + v_off + hh * 128, (size_t)dil * N, SEQ / dil, blk * 256, 64, -1e30f, 0.f, 1,
                                  nullptr, 0, qp, (size_t)dil * N, lse + (size_t)gi * CM * 12 + ((size_t)b * SEQ + cls) * 12 + hh, (size_t)dil * 12);
                    } else {
                        const int b = u / 192, rem = u % 192, hh = rem >> 4, R = rem & 15;
                        const bf16* pb = proj + (size_t)b * SEQ * N;
                        nbr_unit(lds, pb + hh * 128, pb + k_off + hh * 128, pb + v_off + hh * 128, N, a.rpb_c + hh * 465, R,
                                 pb + gate_off + hh * 128, ybuf + (size_t)b * SEQ * DINNER + hh * 128);
                    }
                }
            }
            grid.sync();
            if (kind == 1) { TID_VARS combine_b(proj, lse, ybuf, gtid, gn); grid.sync(); }
            {
                pg8::Gemm g{ybuf, wout_t + (size_t)l * DM * DINNER, CM, DM, DINNER}; pg8::StaticOrder S; S.init(CM, DM, G, bx);
                EpiResid E{(l == 0 ? a.x : a.out) + (size_t)c * CM * DM, a.out + (size_t)c * CM * DM};
                pg8::gemm_phase<EpiResid, pg8::StaticOrder, true, true>(lds, g, S, E);
            }
            grid.sync();
            { TID_VARS ln_rows(a.out + (size_t)c * CM * DM, a.out + (size_t)c * CM * DM, xn + (size_t)c * CM * DM, a.ln_g + l * DM, a.ln_b + l * DM, CM, gw, ngw, lane); }
            grid.sync();
        }
    }
}

extern "C" void kernel_launch(void* const* d_in, const int* in_sizes, int n_in, void* d_out, int out_size, void* d_ws, size_t ws_size, hipStream_t stream) {
    static int grid_blocks = 0;
    if (grid_blocks == 0) {
        if (n_in != 11 || ws_size < WS_END) { fprintf(stderr, "kernel_launch: unexpected inputs (n_in %d, ws %zu)\n", n_in, ws_size); grid_blocks = -1; return; }
        int dev = 0, cus = 0, per_cu = 0;
        hipGetDevice(&dev);
        hipDeviceGetAttribute(&cus, hipDeviceAttributeMultiprocessorCount, dev);
        hipFuncSetAttribute((const void*)fwd_megakernel, hipFuncAttributeMaxDynamicSharedMemorySize, LDS_BYTES);
        hipOccupancyMaxActiveBlocksPerMultiprocessor(&per_cu, (const void*)fwd_megakernel, NTHR, LDS_BYTES);
        if (per_cu < 1) per_cu = 1;
        grid_blocks = cus * per_cu;
        fprintf(stderr, "kernel_launch: cus %d per_cu %d grid %d ws %zu\n", cus, per_cu, grid_blocks, ws_size);
    }
    if (grid_blocks < 0) return;
    Args a{};
    a.x = (const float*)d_in[0]; a.mem = (const float*)d_in[1]; a.w_in_a = (const float*)d_in[2]; a.sink_a = (const float*)d_in[3];
    a.w_in_b = (const float*)d_in[4]; a.w_in_c = (const float*)d_in[5]; a.rpb_c = (const float*)d_in[6]; a.w_mkv = (const float*)d_in[7];
    a.w_out = (const float*)d_in[8]; a.ln_g = (const float*)d_in[9]; a.ln_b = (const float*)d_in[10]; a.out = (float*)d_out; a.ws = (unsigned char*)d_ws;
    void* args[] = {&a};
    hipError_t e = hipLaunchCooperativeKernel((const void*)fwd_megakernel, dim3(grid_blocks), dim3(NTHR), args, LDS_BYTES, stream);
    if (e != hipSuccess) fprintf(stderr, "cooperative launch failed: %s (grid %d)\n", hipGetErrorString(e), grid_blocks);
}
```

```cpp
#include <hip/hip_runtime.h>
#include <hip/hip_cooperative_groups.h>
#include <hip/hip_bf16.h>
#include <cstdio>
#include <cstdint>
namespace cg = cooperative_groups;
namespace pg8 {
#define PG8_LAS __attribute__((address_space(3)))
typedef unsigned short bf16_t;
typedef short bf16x8 __attribute__((ext_vector_type(8)));
typedef float f32x4 __attribute__((ext_vector_type(4)));
typedef unsigned u32x4 __attribute__((ext_vector_type(4)));
constexpr int BM = 256, BK = 64, HALF = 128, HTB = HALF * BK * 2  , STAGE_BYTES = 8 * HTB, NXCD = 8, WGM = 8;

__host__ __device__ __forceinline__ int lds_byte(int r, int c) { const int st = (r >> 4) * 2 + (c >> 5), rr = r & 15, cc = c & 31, ob = rr * 64 + cc * 2; return st * 1024 + (ob ^ (((ob >> 9) & 1) << 5)); }
__host__ __device__ __forceinline__ void stage_rc(int b, int& R, int& C) { const int st = b / 1024, sb = b % 1024, swz = sb ^ (((sb >> 9) & 1) << 5); R = (st >> 1) * 16 + swz / 64; C = (st & 1) * 32 + (swz % 64) / 2; }
__host__ __device__ __forceinline__ int perm32(int rho) { const int n = rho >> 4, i = rho & 15; return 8 * (i >> 2) + 4 * n + (i & 3); }

struct Unit { int pm, pn; };
struct Gemm { const bf16_t* A; const bf16_t* Bt; int M, N, K; };

struct StaticOrder {
    int nM, nN, nwg, G, c;
    __host__ __device__ void init(int M, int N, int G_, int c_) { nM = M / BM; nN = N / BM; nwg = nM * nN; G = G_; c = c_; }
    __host__ __device__ bool next(int i, Unit& u) const {
        const long L = (long)i * G + c; if (L >= nwg) return false;
        int wgid = (int)L; { const int q = nwg / NXCD, r = nwg % NXCD, xcd = wgid % NXCD, off = wgid / NXCD; wgid = (xcd < r ? xcd * (q + 1) : r * (q + 1) + (xcd - r) * q) + off; }
        const int nig = WGM * nN, gid = wgid / nig, fm = gid * WGM, gsz = (nM - fm) < WGM ? (nM - fm) : WGM;
        u.pm = fm + ((wgid % nig) % gsz); u.pn = (wgid % nig) / gsz; return true;
    }
    __device__ __forceinline__ void a_ready(const Unit&) const {}
    __device__ __forceinline__ void done(const Unit&) const {}
};

__device__ __forceinline__ unsigned cvt_pk_bf16(float lo, float hi) { unsigned r; asm volatile("v_cvt_pk_bf16_f32 %0, %1, %2" : "=v"(r) : "v"(lo), "v"(hi)); return r; }
typedef float f32x2 __attribute__((ext_vector_type(2)));
__device__ __forceinline__ f32x2 gelu_pk(f32x2 v) {
    const f32x2 av = __builtin_elementwise_abs(v), d = av * 0.2316418882f + 1.0f;
    f32x2 t; t.x = __builtin_amdgcn_rcpf(d.x); t.y = __builtin_amdgcn_rcpf(d.y);
    f32x2 q = t * 0.5307027145f + (-0.7265760135f); q = q * t + 0.7107068705f; q = q * t + (-0.142248368f); q = q * t + 0.127414796f; q = q * t;
    const f32x2 s = (v * v) * (-0.72134752044f);
    f32x2 e; e.x = __builtin_amdgcn_exp2f(s.x); e.y = __builtin_amdgcn_exp2f(s.y);
    const f32x2 m = v * (q * e), r = v - m;
    f32x2 o; o.x = v.x < 0.f ? m.x : r.x; o.y = v.y < 0.f ? m.y : r.y; return o;
}

template <int ACT  > struct EpiBf16 {
    static constexpr bool PERM = true, AFTER_DRAIN = false; static_assert(ACT == 0 || ACT == 1, "EpiBf16: ACT is 0 (none) or 1 (gelu_pk)");
    bf16_t* O; int ldc; const float* bias; int split_cols; size_t split_stride; float scale0;
    __device__ __forceinline__ void operator()(const f32x4 (&acc)[2][2][4][2], const Unit& u, int wr, int wc, int fr, int fq) const {
        const int row0 = u.pm * BM + wr * 64 + fr; int colt = u.pn * BM; bf16_t* base = O;
        float sc = 1.f; if (split_cols) { const int t = colt / split_cols; base += (size_t)t * split_stride; colt -= t * split_cols; if (t == 0) sc = scale0; }
        const int col0 = colt + wc * 32 + 8 * fq, bcol0 = u.pn * BM + wc * 32 + 8 * fq;
        f32x4 bv[2][2];
#pragma unroll
        for (int bj = 0; bj < 2; ++bj)
#pragma unroll
            for (int n = 0; n < 2; ++n) bv[bj][n] = bias ? *(const f32x4*)(bias + bcol0 + bj * HALF + 4 * n) : (f32x4){0.f, 0.f, 0.f, 0.f};
#pragma unroll
        for (int ai = 0; ai < 2; ++ai)
#pragma unroll
            for (int m = 0; m < 4; ++m) { bf16_t* rowp = base + (size_t)(row0 + ai * HALF + m * 16) * ldc + col0;
#pragma unroll
                for (int bj = 0; bj < 2; ++bj) { f32x4 v0 = acc[ai][bj][m][0] + bv[bj][0], v1 = acc[ai][bj][m][1] + bv[bj][1];
                    if (ACT == 1) { f32x2 a = gelu_pk((f32x2){v0[0], v0[1]}), b = gelu_pk((f32x2){v0[2], v0[3]}), c = gelu_pk((f32x2){v1[0], v1[1]}), d = gelu_pk((f32x2){v1[2], v1[3]});
                        v0 = (f32x4){a.x, a.y, b.x, b.y}; v1 = (f32x4){c.x, c.y, d.x, d.y}; }
                    v0 = v0 * sc; v1 = v1 * sc; u32x4 w; w.x = cvt_pk_bf16(v0[0], v0[1]); w.y = cvt_pk_bf16(v0[2], v0[3]); w.z = cvt_pk_bf16(v1[0], v1[1]); w.w = cvt_pk_bf16(v1[2], v1[3]);
                    *(u32x4*)(rowp + bj * HALF) = w; } }
    }
};

struct PanelStats {
    unsigned* xbuf;
    unsigned* cnt;
    unsigned* tmo;
    int ntn; float eps;
    unsigned code;
    __device__ __forceinline__ bool run(const f32x4 (&v)[2][2][4][2], const Unit& u, int wr, int wc, int fr, int fq, PG8_LAS unsigned char* lds, int wid, int lane) const {
        typedef float f32x2v __attribute__((ext_vector_type(2)));
        PG8_LAS f32x2v* P = (PG8_LAS f32x2v*)lds;
        PG8_LAS f32x2v* S = (PG8_LAS f32x2v*)(lds + 8192);
        PG8_LAS unsigned* flag = (PG8_LAS unsigned*)(lds + 8192 + 2048);
#pragma unroll
        for (int ai = 0; ai < 2; ++ai)
#pragma unroll
            for (int m = 0; m < 4; ++m) {
                float s = 0.f;
#pragma unroll
                for (int bj = 0; bj < 2; ++bj)
#pragma unroll
                    for (int n = 0; n < 2; ++n) { const f32x4 x = v[ai][bj][m][n]; s += (x[0] + x[1]) + (x[2] + x[3]); }
                s += __shfl_xor(s, 16); s += __shfl_xor(s, 32);
                const float mw = s * (1.0f / 64.0f); float q = 0.f;
#pragma unroll
                for (int bj = 0; bj < 2; ++bj)
#pragma unroll
                    for (int n = 0; n < 2; ++n) { const f32x4 d = v[ai][bj][m][n] - mw; q += (d[0] * d[0] + d[1] * d[1]) + (d[2] * d[2] + d[3] * d[3]); }
                q += __shfl_xor(q, 16); q += __shfl_xor(q, 32);
                if (fq == 0) P[(ai * HALF + wr * 64 + m * 16 + fr) * 4 + wc] = (f32x2v){mw, q};
            }
        asm volatile("s_waitcnt lgkmcnt(0)" ::: "memory"); __builtin_amdgcn_s_barrier(); asm volatile("" ::: "memory");
#if defined(BROKEN_EXCHANGE_NO_WAIT)
#warning BROKEN CONTROL BUILD: the row-statistics exchange does not wait; results are wrong by design
        if (blockIdx.x >= 64) { const long long t0_ = clock64(); while (clock64() - t0_ < 60000) __builtin_amdgcn_s_sleep(8); }
#endif
        const int row = wid * 32 + (lane & 31);
        if (lane < 32) {
            const f32x2v a = P[row * 4 + 0], b = P[row * 4 + 1], c = P[row * 4 + 2], d = P[row * 4 + 3];
            const float mt = (a.x + b.x + c.x + d.x) * 0.25f;
            const float da = a.x - mt, db = b.x - mt, dc = c.x - mt, dd = d.x - mt;
            const float m2 = (a.y + b.y) + (c.y + d.y) + 64.0f * ((da * da + db * db) + (dc * dc + dd * dd));
            unsigned long long* slot = (unsigned long long*)xbuf + ((size_t)(u.pm * BM + row) * 4 + u.pn);
            __hip_atomic_store(slot, ((unsigned long long)__float_as_uint(m2) << 32) | __float_as_uint(mt), __ATOMIC_RELAXED, __HIP_MEMORY_SCOPE_AGENT);
        }
        asm volatile("s_waitcnt vmcnt(0)" ::: "memory");
        if (lane == 0) __hip_atomic_fetch_add(cnt + 64 * u.pm, 1u, __ATOMIC_RELAXED, __HIP_MEMORY_SCOPE_AGENT);
        if (wid == 0) {
            bool dead = false; const unsigned long long t0 = __builtin_amdgcn_s_memrealtime(); const unsigned want = 8u * (unsigned)ntn;
            for (;;) {
#if defined(BROKEN_EXCHANGE_NO_WAIT)
                break;
#endif
                if ((unsigned)__builtin_amdgcn_readfirstlane(__hip_atomic_load(cnt + 64 * u.pm, __ATOMIC_RELAXED, __HIP_MEMORY_SCOPE_AGENT)) >= want) break;
                if (__builtin_amdgcn_s_memrealtime() - t0 > 2000000ull) {
                    if (lane == 0) { unsigned expect = 0u; __hip_atomic_compare_exchange_strong(tmo + 1, &expect, code | (unsigned)(u.pm & 0xff), __ATOMIC_RELAXED, __ATOMIC_RELAXED, __HIP_MEMORY_SCOPE_AGENT);
                                     __hip_atomic_store(tmo, 1u, __ATOMIC_RELAXED, __HIP_MEMORY_SCOPE_AGENT); }
                    dead = true; break; }
                __builtin_amdgcn_s_sleep(2);
            }
            __builtin_amdgcn_fence(__ATOMIC_ACQUIRE, "agent");
            if (lane == 0) flag[0] = dead ? 1u : 0u;
        }
        asm volatile("s_waitcnt vmcnt(0) lgkmcnt(0)" ::: "memory"); __builtin_amdgcn_s_barrier(); asm volatile("" ::: "memory");
        const bool bad = flag[0] != 0u;
        if (lane < 32) {
            const unsigned long long* slot = (const unsigned long long*)xbuf + (size_t)(u.pm * BM + row) * 4; float mt[4], m2[4]; float ms = 0.f;
#pragma unroll
            for (int t = 0; t < 4; ++t) { if (t < ntn) { const unsigned long long w = __hip_atomic_load(slot + t, __ATOMIC_RELAXED, __HIP_MEMORY_SCOPE_AGENT); mt[t] = __uint_as_float((unsigned)w); m2[t] = __uint_as_float((unsigned)(w >> 32)); } else { mt[t] = 0.f; m2[t] = 0.f; } ms += mt[t]; }
            const float mean = ms / (float)ntn; float q = 0.f;
#pragma unroll
            for (int t = 0; t < 4; ++t) if (t < ntn) { const float dm = mt[t] - mean; q += m2[t] + 256.0f * dm * dm; }
            S[row] = (f32x2v){mean, 1.0f / sqrtf(q / (256.0f * (float)ntn) + eps)};
        }
        asm volatile("s_waitcnt lgkmcnt(0)" ::: "memory"); __builtin_amdgcn_s_barrier(); asm volatile("" ::: "memory");
        return bad;
    }
};
struct EpiLnRes {
    static constexpr bool PERM = false, AFTER_DRAIN = true;
    const float* base; float* out; int ldc; const float* bias; PanelStats st; unsigned poison;
    __device__ __forceinline__ void fused(f32x4 (&acc)[2][2][4][2], const Unit& u, int wr, int wc, int fr, int fq, PG8_LAS unsigned char* lds, int wid, int lane) const {
        typedef float f32x2v __attribute__((ext_vector_type(2)));
        const PG8_LAS f32x2v* S = (const PG8_LAS f32x2v*)(lds + 8192);
        const int col0 = u.pn * BM + wc * 32 + 4 * fq;
#pragma unroll
        for (int bj = 0; bj < 2; ++bj)
#pragma unroll
            for (int n = 0; n < 2; ++n) { const f32x4 bv = bias ? *(const f32x4*)(bias + col0 + bj * HALF + n * 16) : (f32x4){0.f, 0.f, 0.f, 0.f};
#pragma unroll
                for (int ai = 0; ai < 2; ++ai)
#pragma unroll
                    for (int m = 0; m < 4; ++m) acc[ai][bj][m][n] += bv; }
        f32x4 pre[4][2][2];
#pragma unroll
        for (int m = 0; m < 4; ++m) { const size_t off = (size_t)(u.pm * BM + wr * 64 + m * 16 + fr) * ldc + col0;
#pragma unroll
            for (int bj = 0; bj < 2; ++bj)
#pragma unroll
                for (int n = 0; n < 2; ++n) pre[m][bj][n] = *(const f32x4*)(base + off + bj * HALF + n * 16); }
        const bool bad = st.run(acc, u, wr, wc, fr, fq, lds, wid, lane) || poison != 0u;
        const float qnan = __builtin_nanf("");
#pragma unroll
        for (int ai = 0; ai < 2; ++ai)
#pragma unroll
            for (int m = 0; m < 4; ++m) { const int r = ai * HALF + wr * 64 + m * 16 + fr; const f32x2v sr = S[r]; const size_t off = (size_t)(u.pm * BM + r) * ldc + col0;
#pragma unroll
                for (int bj = 0; bj < 2; ++bj)
#pragma unroll
                    for (int n = 0; n < 2; ++n) { const f32x4 bs = ai == 0 ? pre[m][bj][n] : *(const f32x4*)(base + off + bj * HALF + n * 16); f32x4 o = bs + (acc[ai][bj][m][n] - sr.x) * sr.y;
                        if (bad) o = (f32x4){qnan, qnan, qnan, qnan}; *(f32x4*)(out + off + bj * HALF + n * 16) = o; }
                if (m & 1) asm volatile("" ::: "memory"); }
    }
};
struct EpiLnResLn {
    static constexpr bool PERM = false, AFTER_DRAIN = true;
    const float* base; float* out; bf16_t* xn; int ldc; const float* bias; PanelStats st1, st2; unsigned poison;
    __device__ __forceinline__ void fused(f32x4 (&acc)[2][2][4][2], const Unit& u, int wr, int wc, int fr, int fq, PG8_LAS unsigned char* lds, int wid, int lane) const {
        typedef float f32x2v __attribute__((ext_vector_type(2))); typedef unsigned u32x2v __attribute__((ext_vector_type(2)));
        const PG8_LAS f32x2v* S = (const PG8_LAS f32x2v*)(lds + 8192);
        const int col0 = u.pn * BM + wc * 32 + 4 * fq;
#pragma unroll
        for (int bj = 0; bj < 2; ++bj)
#pragma unroll
            for (int n = 0; n < 2; ++n) { const f32x4 bv = bias ? *(const f32x4*)(bias + col0 + bj * HALF + n * 16) : (f32x4){0.f, 0.f, 0.f, 0.f};
#pragma unroll
                for (int ai = 0; ai < 2; ++ai)
#pragma unroll
                    for (int m = 0; m < 4; ++m) acc[ai][bj][m][n] += bv; }
        bool bad = st1.run(acc, u, wr, wc, fr, fq, lds, wid, lane) || poison != 0u;
        const float qnan = __builtin_nanf("");
#pragma unroll
        for (int ai = 0; ai < 2; ++ai)
#pragma unroll
            for (int m = 0; m < 4; ++m) { const int r = ai * HALF + wr * 64 + m * 16 + fr; const f32x2v sr = S[r]; const size_t off = (size_t)(u.pm * BM + r) * ldc + col0;
#pragma unroll
                for (int bj = 0; bj < 2; ++bj)
#pragma unroll
                    for (int n = 0; n < 2; ++n) { const f32x4 bs = *(const f32x4*)(base + off + bj * HALF + n * 16); acc[ai][bj][m][n] = bs + (acc[ai][bj][m][n] - sr.x) * sr.y; }
                asm volatile("" : "+v"(acc[ai][0][m][0]), "+v"(acc[ai][0][m][1]), "+v"(acc[ai][1][m][0]), "+v"(acc[ai][1][m][1]));
                if (m & 1) asm volatile("" ::: "memory"); }
        const bool bad1 = bad;
        bad = st2.run(acc, u, wr, wc, fr, fq, lds, wid, lane) || bad;
#pragma unroll
        for (int ai = 0; ai < 2; ++ai)
#pragma unroll
            for (int m = 0; m < 4; ++m) { const int r = ai * HALF + wr * 64 + m * 16 + fr; const f32x2v sr = S[r]; const size_t off = (size_t)(u.pm * BM + r) * ldc + col0;
#pragma unroll
                for (int bj = 0; bj < 2; ++bj)
#pragma unroll
                    for (int n = 0; n < 2; ++n) { const f32x4 x1 = acc[ai][bj][m][n]; *(f32x4*)(out + off + bj * HALF + n * 16) = bad1 ? (f32x4){qnan, qnan, qnan, qnan} : x1;
                        const f32x4 o = (x1 - sr.x) * sr.y; u32x2v w; w.x = cvt_pk_bf16(o[0], o[1]); w.y = cvt_pk_bf16(o[2], o[3]);
                        if (bad) { w.x = 0x7fc07fc0u; w.y = 0x7fc07fc0u; } *(u32x2v*)(xn + off + bj * HALF + n * 16) = w; }
                asm volatile("" ::: "memory"); }
    }
};

template <class Epi, class Sched, bool ALIGN_EPI = false, bool SP2 = false>
__device__ __forceinline__ void gemm_phase(PG8_LAS unsigned char* lds, const Gemm g, const Sched& S, const Epi& E) {
    int tid = threadIdx.x; asm volatile("" : "+v"(tid)); const int wid = __builtin_amdgcn_readfirstlane(tid >> 6), lane = tid & 63, wr = wid >> 2, wc = wid & 3, fr = lane & 15, fq = lane >> 4;
    const int K = g.K, nt = K / BK;
    unsigned voffA[2], voffB[2];
#pragma unroll
    for (int i = 0; i < 2; ++i) { int R, C; stage_rc(tid * 16 + i * 8192, R, C); const int Rb = Epi::PERM ? ((R & ~31) + perm32(R & 31)) : R;
        voffA[i] = (unsigned)(R * K + C) * 2u; voffB[i] = (unsigned)(Rb * K + C) * 2u; }
    const size_t kstep = (size_t)(BK * 2);
    const size_t hstep = (size_t)HALF * K * 2;
    const size_t tstep = 2 * hstep;
    const unsigned ldsw = (unsigned)wid * 1024u;
    const int aoff = lds_byte(wr * 64 + fr, fq * 8), boff = lds_byte(wc * 32 + fr, fq * 8);
#define PG8_SA(b, h) (((b) * 2 + (h)) * HTB)
#define PG8_SB(b, h) ((4 + (b) * 2 + (h)) * HTB)
#define PG8_STAGE(bufoff, gbase, voff) do { _Pragma("unroll") for (int _i = 0; _i < 2; ++_i) \
        __builtin_amdgcn_global_load_lds((const unsigned*)((const char*)(gbase) + (voff)[_i]), (PG8_LAS unsigned*)(lds + (bufoff) + ldsw + _i * 8192), 16, 0, 0); } while (0)
#define PG8_LDA(dst, b, h) do { _Pragma("unroll") for (int m = 0; m < 4; ++m) _Pragma("unroll") for (int k = 0; k < 2; ++k) dst[m][k] = *(const PG8_LAS bf16x8*)(lds + PG8_SA(b, h) + aoff + m * 2048 + k * 1024); } while (0)
#define PG8_LDB(dst, b, h) do { _Pragma("unroll") for (int n = 0; n < 2; ++n) _Pragma("unroll") for (int k = 0; k < 2; ++k) dst[n][k] = *(const PG8_LAS bf16x8*)(lds + PG8_SB(b, h) + boff + n * 2048 + k * 1024); } while (0)
#define PG8_MMA(ai, bj, At, Bt) do { __builtin_amdgcn_s_setprio(1); _Pragma("unroll") for (int m = 0; m < 4; ++m) _Pragma("unroll") for (int n = 0; n < 2; ++n) _Pragma("unroll") for (int k = 0; k < 2; ++k) \
        acc[ai][bj][m][n] = __builtin_amdgcn_mfma_f32_16x16x32_bf16(Bt[n][k], At[m][k], acc[ai][bj][m][n], 0, 0, 0); __builtin_amdgcn_s_setprio(0); } while (0)
#define PG8_WAIT_V(n) asm volatile("s_waitcnt vmcnt(" #n ")" ::: "memory")
#define PG8_WAIT_L(n) asm volatile("s_waitcnt lgkmcnt(" #n ")" ::: "memory")
#define PG8_BAR __builtin_amdgcn_s_barrier()
#define PG8_SCHED __builtin_amdgcn_sched_barrier(0)
    Unit cur, nxt; int ui = 0;
    if (!S.next(0, cur)) return;
    f32x4 acc[2][2][4][2];
#pragma unroll
    for (int a = 0; a < 2; ++a)
#pragma unroll
        for (int b = 0; b < 2; ++b)
#pragma unroll
            for (int m = 0; m < 4; ++m)
#pragma unroll
                for (int n = 0; n < 2; ++n) acc[a][b][m][n] = (f32x4){0.f, 0.f, 0.f, 0.f};
    bf16x8 At[4][2], B0[2][2], B1[2][2];
    const char* cA = (const char*)g.A + (size_t)cur.pm * tstep; const char* cB = (const char*)g.Bt + (size_t)cur.pn * tstep;
    S.a_ready(cur);
    if constexpr (SP2) {
        PG8_STAGE(PG8_SB(0, 0), cB, voffB); PG8_STAGE(PG8_SB(0, 1), cB + hstep, voffB); PG8_STAGE(PG8_SA(0, 0), cA, voffA); PG8_STAGE(PG8_SA(0, 1), cA + hstep, voffA);
        if (wr == 1) PG8_BAR;
        PG8_WAIT_V(2); PG8_BAR;
        PG8_STAGE(PG8_SB(1, 0), cB + kstep, voffB); PG8_STAGE(PG8_SA(1, 0), cA + kstep, voffA); PG8_STAGE(PG8_SB(1, 1), cB + hstep + kstep, voffB);
        PG8_WAIT_V(6); PG8_BAR;
    } else {
        PG8_STAGE(PG8_SB(0, 0), cB, voffB); PG8_STAGE(PG8_SA(0, 0), cA, voffA); PG8_STAGE(PG8_SB(0, 1), cB + hstep, voffB); PG8_STAGE(PG8_SA(0, 1), cA + hstep, voffA);
        if (wr == 1) PG8_BAR;
        PG8_WAIT_V(4); PG8_BAR;
        PG8_STAGE(PG8_SB(1, 0), cB + kstep, voffB); PG8_STAGE(PG8_SA(1, 0), cA + kstep, voffA); PG8_STAGE(PG8_SB(1, 1), cB + hstep + kstep, voffB);
        PG8_WAIT_V(6); PG8_BAR;
    }
    for (;;) {
        const bool has_next = S.next(ui + 1, nxt);
        const char* nA = has_next ? (const char*)g.A + (size_t)nxt.pm * tstep : cA; const char* nB = has_next ? (const char*)g.Bt + (size_t)nxt.pn * tstep : cB;
        for (int t = 0; t < nt; t += 2) {
            const bool last = (t == nt - 2);
            const char* a1 = cA + (size_t)(t + 1) * kstep;
            const char* a2 = last ? nA : cA + (size_t)(t + 2) * kstep; const char* b2 = last ? nB : cB + (size_t)(t + 2) * kstep;
            const char* a3 = a2 + kstep; const char* b3 = b2 + kstep;
            if (last && has_next) S.a_ready(nxt);
            if constexpr (SP2) {
            PG8_LDB(B0, 0, 0); PG8_LDB(B1, 0, 1); PG8_SCHED; PG8_LDA(At, 0, 0); PG8_STAGE(PG8_SA(1, 1), a1 + hstep, voffA);
            PG8_WAIT_V(8); PG8_WAIT_L(0); PG8_BAR; PG8_MMA(0, 0, At, B0); PG8_MMA(0, 1, At, B1); PG8_BAR; PG8_SCHED;
            PG8_LDA(At, 0, 1); PG8_STAGE(PG8_SB(0, 0), b2, voffB); PG8_STAGE(PG8_SB(0, 1), b2 + hstep, voffB); PG8_STAGE(PG8_SA(0, 0), a2, voffA);
            PG8_WAIT_V(8); PG8_WAIT_L(0); PG8_BAR; PG8_MMA(1, 0, At, B0); PG8_MMA(1, 1, At, B1); PG8_BAR; PG8_SCHED;
            PG8_LDB(B0, 1, 0); PG8_LDB(B1, 1, 1); PG8_SCHED; PG8_LDA(At, 1, 0); PG8_STAGE(PG8_SA(0, 1), a2 + hstep, voffA);
            PG8_WAIT_V(8); PG8_WAIT_L(0); PG8_BAR; PG8_MMA(0, 0, At, B0); PG8_MMA(0, 1, At, B1); PG8_BAR; PG8_SCHED;
            PG8_LDA(At, 1, 1); PG8_STAGE(PG8_SB(1, 0), b3, voffB); PG8_STAGE(PG8_SB(1, 1), b3 + hstep, voffB); PG8_STAGE(PG8_SA(1, 0), a3, voffA);
            PG8_WAIT_V(8); PG8_WAIT_L(0); PG8_BAR; PG8_MMA(1, 0, At, B0); PG8_MMA(1, 1, At, B1); PG8_BAR; PG8_SCHED;
            } else {
            PG8_LDB(B0, 0, 0); PG8_SCHED; PG8_LDA(At, 0, 0); PG8_STAGE(PG8_SA(1, 1), a1 + hstep, voffA);
            PG8_WAIT_L(8); PG8_BAR; PG8_WAIT_L(0); PG8_MMA(0, 0, At, B0); PG8_BAR; PG8_SCHED;
            PG8_LDB(B1, 0, 1); PG8_STAGE(PG8_SB(0, 0), b2, voffB);
            PG8_BAR; PG8_WAIT_L(0); PG8_MMA(0, 1, At, B1); PG8_BAR;
            PG8_LDA(At, 0, 1); PG8_STAGE(PG8_SA(0, 0), a2, voffA);
            PG8_BAR; PG8_WAIT_L(0); PG8_MMA(1, 0, At, B0); PG8_BAR; PG8_SCHED;
            PG8_STAGE(PG8_SB(0, 1), b2 + hstep, voffB);
            PG8_WAIT_V(6); PG8_BAR; PG8_MMA(1, 1, At, B1); PG8_BAR;
            PG8_LDB(B0, 1, 0); PG8_SCHED; PG8_LDA(At, 1, 0); PG8_STAGE(PG8_SA(0, 1), a2 + hstep, voffA);
            PG8_WAIT_L(8); PG8_BAR; PG8_WAIT_L(0); PG8_MMA(0, 0, At, B0); PG8_BAR; PG8_SCHED;
            PG8_LDB(B1, 1, 1); PG8_STAGE(PG8_SB(1, 0), b3, voffB);
            PG8_BAR; PG8_WAIT_L(0); PG8_MMA(0, 1, At, B1); PG8_BAR;
            PG8_LDA(At, 1, 1); PG8_STAGE(PG8_SA(1, 0), a3, voffA);
            PG8_BAR; PG8_WAIT_L(0); PG8_MMA(1, 0, At, B0); PG8_BAR; PG8_SCHED;
            PG8_STAGE(PG8_SB(1, 1), b3 + hstep, voffB);
            PG8_WAIT_V(6); PG8_BAR; PG8_MMA(1, 1, At, B1); PG8_BAR;
            }
        }
        if constexpr (ALIGN_EPI) { if (wr == 0) PG8_BAR; }
        if constexpr (!Epi::AFTER_DRAIN) { E(acc, cur, wr, wc, fr, fq); S.done(cur); }
        if (!has_next) break;
#pragma unroll
        for (int a = 0; a < 2; ++a)
#pragma unroll
            for (int b = 0; b < 2; ++b)
#pragma unroll
                for (int m = 0; m < 4; ++m)
#pragma unroll
                    for (int n = 0; n < 2; ++n) acc[a][b][m][n] = (f32x4){0.f, 0.f, 0.f, 0.f};
        cur = nxt; cA = nA; cB = nB; ++ui;
        if constexpr (ALIGN_EPI) { if (wr == 1) PG8_BAR; }
    }
    PG8_WAIT_V(0);
    if constexpr (!ALIGN_EPI) { if (wr == 0) PG8_BAR; }
    PG8_BAR;
    if constexpr (Epi::AFTER_DRAIN) { E.fused(acc, cur, wr, wc, fr, fq, lds, wid, lane); S.done(cur); }
#undef PG8_SA
#undef PG8_SB
#undef PG8_STAGE
#undef PG8_LDA
#undef PG8_LDB
#undef PG8_MMA
#undef PG8_WAIT_V
#undef PG8_WAIT_L
#undef PG8_BAR
#undef PG8_SCHED
}
}
#define GAS __attribute__((address_space(1)))
#define LAS __attribute__((address_space(3)))
#define DI __device__ __forceinline__
typedef unsigned short bf16;
typedef unsigned v4u __attribute__((ext_vector_type(4)));
typedef unsigned v2u __attribute__((ext_vector_type(2)));
typedef float f32x4 __attribute__((ext_vector_type(4)));
typedef float f32x16 __attribute__((ext_vector_type(16)));
typedef short bf16x8 __attribute__((ext_vector_type(8)));
typedef short s16x4 __attribute__((ext_vector_type(4)));
#define LDS_WAIT() asm volatile("s_waitcnt lgkmcnt(0)" ::: "memory")

constexpr int DM = 1024, NB = 16, SEQ = 4096, NTOK = NB * SEQ, DEPTH = 4, HD = 128, DINNER = 2048, MEMH = 4, MEML = 256, MIXH = 12;
constexpr int NCHUNK = 4, CB = NB / NCHUNK, CM = CB * SEQ;
constexpr int N_A = 5120, N_B = 10240, N_C = 7168;
constexpr float LN_EPS = 1e-5f;
constexpr float ALPHA = 1.6817928305074290f;
constexpr float LOG2E = 1.4426950408889634f;
constexpr float QSCALE = 0.08838834764831845f * LOG2E;
constexpr int NWAVES = 8, NTHR = 512;

constexpr size_t MiB = 1u << 20;
constexpr size_t WS_CTL = 0, CTL_ZERO_BYTES = 1 * MiB;
constexpr size_t WS_ROPE = 1 * MiB;
constexpr size_t WS_WIN = 2 * MiB;
constexpr size_t WS_WMKV = 56 * MiB;
constexpr size_t WS_WOUT = 64 * MiB;
constexpr size_t WS_MEMB = 80 * MiB;
constexpr size_t WS_MKV = 88 * MiB;
constexpr size_t WS_XN = 120 * MiB;
constexpr size_t WS_PROJ = 248 * MiB;
constexpr size_t WS_Y = 568 * MiB;
constexpr size_t WS_LSE = 632 * MiB;
constexpr size_t WS_END = 636 * MiB;

struct Args {
    const float* x; const float* mem; const float* w_in_a; const float* sink_a; const float* w_in_b; const float* w_in_c; const float* rpb_c;
    const float* w_mkv; const float* w_out; const float* ln_g; const float* ln_b; float* out; unsigned char* ws;
};

DI unsigned f2bf(float f) { unsigned u = __builtin_bit_cast(unsigned, f); return (u + 0x7fffu + ((u >> 16) & 1u)) >> 16; }
DI unsigned pk2(float lo, float hi) { return f2bf(lo) | (f2bf(hi) << 16); }
DI float bf_lo(unsigned u) { return __builtin_bit_cast(float, u << 16); }
DI float bf_hi(unsigned u) { return __builtin_bit_cast(float, u & 0xffff0000u); }
typedef float f32x2_t __attribute__((ext_vector_type(2))); typedef __bf16 bf16x2_t __attribute__((ext_vector_type(2)));
DI unsigned cvtpk(float lo, float hi) { f32x2_t v = {lo, hi}; bf16x2_t b = __builtin_convertvector(v, bf16x2_t); return __builtin_bit_cast(unsigned, b); }
DI float silu(float x) { return x / (1.f + __expf(-x)); }

struct EpiProj {
    static constexpr bool PERM = true, AFTER_DRAIN = false;
    bf16* O; int ldc; int rope_end; int q_end; int mq_off; const float* rope;
    DI void operator()(const pg8::f32x4 (&acc)[2][2][4][2], const pg8::Unit& u, int wr, int wc, int fr, int fq) const {
        const int colt = u.pn * 256;
        const bool do_rope = (colt < rope_end) && (wc == 0);
        const float sc = (colt < q_end || (colt >= mq_off && colt < mq_off + 512)) ? QSCALE : 1.f;
        const int row0 = u.pm * 256 + wr * 64 + fr, col0 = colt + wc * 32 + 8 * fq;
#pragma unroll
        for (int ai = 0; ai < 2; ++ai)
#pragma unroll
            for (int m = 0; m < 4; ++m) {
                const int row = row0 + ai * 128 + m * 16;
                bf16* rowp = O + (size_t)row * ldc + col0;
                f32x4 cs0 = {1.f, 0.f, 1.f, 0.f}, cs1 = cs0, cs2 = cs0, cs3 = cs0;
                if (do_rope) { const f32x4* rp = (const f32x4*)(rope + ((size_t)(row & (SEQ - 1)) * 16 + 8 * (fq & 1)) * 2);
                    cs0 = rp[0]; cs1 = rp[1]; cs2 = rp[2]; cs3 = rp[3]; }
#pragma unroll
                for (int bj = 0; bj < 2; ++bj) {
                    f32x4 v0 = acc[ai][bj][m][0], v1 = acc[ai][bj][m][1];
                    if (do_rope) {
                        f32x4 p0, p1;
#pragma unroll
                        for (int e = 0; e < 4; ++e) { p0[e] = __shfl_xor(v0[e], 32); p1[e] = __shfl_xor(v1[e], 32); }
                        const float sg = (fq < 2) ? -1.f : 1.f;
                        v0[0] = v0[0] * cs0[0] + sg * p0[0] * cs0[1]; v0[1] = v0[1] * cs0[2] + sg * p0[1] * cs0[3];
                        v0[2] = v0[2] * cs1[0] + sg * p0[2] * cs1[1]; v0[3] = v0[3] * cs1[2] + sg * p0[3] * cs1[3];
                        v1[0] = v1[0] * cs2[0] + sg * p1[0] * cs2[1]; v1[1] = v1[1] * cs2[2] + sg * p1[1] * cs2[3];
                        v1[2] = v1[2] * cs3[0] + sg * p1[2] * cs3[1]; v1[3] = v1[3] * cs3[2] + sg * p1[3] * cs3[3];
                    }
                    v0 = v0 * sc; v1 = v1 * sc;
                    pg8::u32x4 w; w.x = pg8::cvt_pk_bf16(v0[0], v0[1]); w.y = pg8::cvt_pk_bf16(v0[2], v0[3]); w.z = pg8::cvt_pk_bf16(v1[0], v1[1]); w.w = pg8::cvt_pk_bf16(v1[2], v1[3]);
                    *(pg8::u32x4*)(rowp + bj * 128) = w;
                }
            }
    }
};
struct EpiResid {
    static constexpr bool PERM = false, AFTER_DRAIN = false;
    const float* xin; float* zout;
    DI void operator()(const pg8::f32x4 (&acc)[2][2][4][2], const pg8::Unit& u, int wr, int wc, int fr, int fq) const {
        const int col0 = u.pn * 256 + wc * 32 + 4 * fq;
#pragma unroll
        for (int ai = 0; ai < 2; ++ai)
#pragma unroll
            for (int m = 0; m < 4; ++m) {
                const size_t off = (size_t)(u.pm * 256 + ai * 128 + wr * 64 + m * 16 + fr) * DM + col0;
#pragma unroll
                for (int bj = 0; bj < 2; ++bj)
#pragma unroll
                    for (int n = 0; n < 2; ++n) { const f32x4 b = *(const f32x4*)(xin + off + bj * 128 + n * 16);
                        *(f32x4*)(zout + off + bj * 128 + n * 16) = b * ALPHA + acc[ai][bj][m][n]; }
                asm volatile("" ::: "memory");
            }
    }
};
#define XB_TMO      128
#define XB_XCNT(j)  (256  + 64 * (j))
#define XB_XSUB(j)  (1280 + 64 * (j))
#define XB_XGEN(j)  (2304 + 64 * (j))
#define XB_TOP      3328
#define XB_TOPGEN   3392
#define XCD_BAR_WORDS 3456
#define XB_SPIN_CAP (1u << 18)

__device__ __forceinline__ unsigned xb_ld(unsigned* p)              { return __hip_atomic_load(p, __ATOMIC_RELAXED, __HIP_MEMORY_SCOPE_AGENT); }
__device__ __forceinline__ unsigned xb_add(unsigned* p, unsigned v) { return __hip_atomic_fetch_add(p, v, __ATOMIC_RELAXED, __HIP_MEMORY_SCOPE_AGENT); }
__device__ __forceinline__ unsigned xb_xcc_id() { return (unsigned)__builtin_amdgcn_s_getreg((3 << 11) | 20) & 0xFu; }
#define XB_SPIN(cond, bar) do { unsigned _sp = 0; while (cond) { __builtin_amdgcn_s_sleep(1); \
    if ((++_sp & 255u) == 0u) { if (xb_ld(&(bar)[XB_TMO])) break; if (_sp > XB_SPIN_CAP) { atomicAdd(&(bar)[XB_TMO], 1u); break; } } } } while (0)

struct XcdBarrier {
    unsigned* bar; unsigned x;
    volatile LAS unsigned* st;
};

__device__ __forceinline__ XcdBarrier xcd_barrier_post(unsigned* bar, volatile LAS unsigned* st) {
    XcdBarrier b; b.bar = bar; b.x = xb_xcc_id(); b.st = st;
    if (threadIdx.x == 0) (void)xb_add(&bar[XB_XCNT(b.x)], 1u);
    return b;
}
__device__ __forceinline__ void xcd_barrier_complete(unsigned* bar, unsigned x, unsigned& nloc, unsigned& nx) {
    const unsigned G = gridDim.x * gridDim.y * gridDim.z;
    unsigned sum, cnt, mine, sp = 0u;
    for (;;) {
        sum = 0u; cnt = 0u; mine = 0u;
#pragma unroll
        for (unsigned j = 0; j < 16; ++j) { const unsigned c = xb_ld(&bar[XB_XCNT(j)]); sum += c; cnt += (c > 0u) ? 1u : 0u; mine = (j == x) ? c : mine; }
        if (sum == G) break;
        __builtin_amdgcn_s_sleep(1);
        if ((++sp & 255u) == 0u) { if (xb_ld(&bar[XB_TMO])) break; if (sp > XB_SPIN_CAP) { atomicAdd(&bar[XB_TMO], 1u); break; } }
    }
    nloc = mine > 0u ? mine : 1u; nx = cnt > 0u ? cnt : 1u;
}

__device__ __forceinline__ void xcd_barrier(const XcdBarrier& b) {
    asm volatile("s_waitcnt vmcnt(0)" ::: "memory");
    __syncthreads();
    if (threadIdx.x == 0) {
        unsigned* bar = b.bar;
        __builtin_amdgcn_s_waitcnt(0);
        unsigned nloc = b.st[0], nx = b.st[1];
        if (nloc == 0u) { xcd_barrier_complete(bar, b.x, nloc, nx); b.st[0] = nloc; b.st[1] = nx; }
        const unsigned old = xb_add(&bar[XB_XSUB(b.x)], 1u);
        const unsigned gen = old / nloc;
        if (old + 1u == (gen + 1u) * nloc) {
            __builtin_amdgcn_fence(__ATOMIC_RELEASE, "agent");
            asm volatile("s_waitcnt vmcnt(0)" ::: "memory");
            const unsigned og = xb_add(&bar[XB_TOP], 1u);
            const unsigned tg = og / nx;
            if (og + 1u == (tg + 1u) * nx) xb_add(&bar[XB_TOPGEN], 1u);
            else XB_SPIN(xb_ld(&bar[XB_TOPGEN]) == tg, bar);
            __builtin_amdgcn_fence(__ATOMIC_ACQUIRE, "agent");
            xb_add(&bar[XB_XGEN(b.x)], 1u);
            asm volatile("s_waitcnt vmcnt(0)" ::: "memory");
        } else {
            XB_SPIN(xb_ld(&bar[XB_XGEN(b.x)]) == gen, bar);
            __builtin_amdgcn_fence(__ATOMIC_ACQUIRE, "agent");
            asm volatile("s_waitcnt vmcnt(0)" ::: "memory");
        }
    }
    __syncthreads();
}


DI float wave_sum(float v) {
#pragma unroll
    for (int o = 1; o < 64; o <<= 1) v += __shfl_xor(v, o);
    return v;
}
DI void p0_transpose_item(const float* W, int K, int N, bf16* WT, int row_off, LAS float* scr, int item, int lane) {
    const int nblk = N / 32, kb = item / nblk, nb = item % nblk, k0 = 64 * kb, n0 = 32 * nb;
#pragma unroll 8
    for (int i = 0; i < 32; ++i) { const int kk = 2 * i + (lane >> 5); scr[kk * 33 + (lane & 31)] = W[(size_t)(k0 + kk) * N + n0 + (lane & 31)]; }
    LDS_WAIT(); asm volatile("" ::: "memory");
    const int c = lane & 7;
#pragma unroll
    for (int j = 0; j < 4; ++j) { const int n = (lane >> 3) + 8 * j; const LAS float* s = scr + (8 * c) * 33 + n;
        v4u o; o.x = pk2(s[0 * 33], s[1 * 33]); o.y = pk2(s[2 * 33], s[3 * 33]); o.z = pk2(s[4 * 33], s[5 * 33]); o.w = pk2(s[6 * 33], s[7 * 33]);
        *(v4u*)(WT + (size_t)(row_off + n0 + n) * K + k0 + 8 * c) = o; }
    LDS_WAIT(); asm volatile("" ::: "memory");
}
DI void cvt_rows(const float* src, bf16* dst, size_t n8, size_t gtid, size_t gn) {
    for (size_t i = gtid; i < n8; i += gn) {
        const f32x4 a = *(const f32x4*)(src + i * 8), b = *(const f32x4*)(src + i * 8 + 4);
        v4u o; o.x = cvtpk(a[0], a[1]); o.y = cvtpk(a[2], a[3]); o.z = cvtpk(b[0], b[1]); o.w = cvtpk(b[2], b[3]);
        *(v4u*)(dst + i * 8) = o;
    }
}

constexpr int KROWB = 272, VOFF = 64 * KROWB, VBLK = 64 * 64, BOFF = VOFF + 4 * VBLK, ATT_LDS = BOFF + 2048;
typedef const LAS char* ldsc;
typedef short v4i16_t __attribute__((ext_vector_type(4)));
DI s16x4 vtr(ldsc p) { return __builtin_bit_cast(s16x4, __builtin_amdgcn_ds_read_tr16_b64_v4i16((LAS v4i16_t*)p)); }
#define MFMA32(a, b, c) __builtin_amdgcn_mfma_f32_32x32x16_bf16((a), (b), (c), 0, 0, 0)
DI int crow0(int r) { return (r & 3) + 8 * (r >> 2); }

struct BandMask { int base, w; unsigned w2; ldsc bias;
    DI float operator()(int r, float s) const { const int d = base + crow0(r); return ((unsigned)(d + w) <= w2) ? s : -INFINITY; } };
struct NbrMask { bool rowvalid; int kc0, cs, bidx; const LAS float* bias;
    DI float operator()(int r, float s) const { const int kc = kc0 + crow0(r); const bool v = rowvalid && ((unsigned)(kc - cs) < 16u);
        const float b = bias[v ? (bidx + kc) : 0]; return v ? (s + b) : -INFINITY; } };

template <class MF>
DI void att_subtile(ldsc kp, ldsc vp, const bf16x8 (&qf)[8], f32x16 (&o)[4], float& m, float& l, const MF& mf) {
    f32x16 s;
#pragma unroll
    for (int i = 0; i < 16; ++i) s[i] = 0.f;
#pragma unroll
    for (int kk = 0; kk < 8; ++kk) { const bf16x8 kf = *(const LAS bf16x8*)(kp + kk * 32); s = MFMA32(kf, qf[kk], s); }
    float mt = -INFINITY;
#pragma unroll
    for (int r = 0; r < 16; ++r) { s[r] = mf(r, s[r]); mt = fmaxf(mt, s[r]); }
    mt = fmaxf(mt, __shfl_xor(mt, 32));
    const float mn = fmaxf(m, mt);
    const float alpha = __builtin_amdgcn_exp2f(m - mn); m = mn;
    float ps = 0.f;
#pragma unroll
    for (int r = 0; r < 16; ++r) { s[r] = __builtin_amdgcn_exp2f(s[r] - mn); ps += s[r]; }
    l = l * alpha + ps;
#pragma unroll
    for (int d = 0; d < 4; ++d) o[d] = o[d] * alpha;
    v4u pa, pb;
    pa.x = cvtpk(s[0], s[1]); pa.y = cvtpk(s[2], s[3]); pa.z = cvtpk(s[4], s[5]); pa.w = cvtpk(s[6], s[7]);
    pb.x = cvtpk(s[8], s[9]); pb.y = cvtpk(s[10], s[11]); pb.z = cvtpk(s[12], s[13]); pb.w = cvtpk(s[14], s[15]);
    const bf16x8 pf0 = __builtin_bit_cast(bf16x8, pa), pf1 = __builtin_bit_cast(bf16x8, pb);
#pragma unroll
    for (int d = 0; d < 4; ++d) {
        const s16x4 lo0 = vtr(vp + d * VBLK), hi0 = vtr(vp + d * VBLK + 8 * 64), lo1 = vtr(vp + d * VBLK + 16 * 64), hi1 = vtr(vp + d * VBLK + 24 * 64);
        const bf16x8 v0 = __builtin_shufflevector(lo0, hi0, 0, 1, 2, 3, 4, 5, 6, 7), v1 = __builtin_shufflevector(lo1, hi1, 0, 1, 2, 3, 4, 5, 6, 7);
        o[d] = MFMA32(v0, pf0, o[d]); o[d] = MFMA32(v1, pf1, o[d]);
    }
}

struct KVRegs { v4u k0, k1, v0, v1; };
DI void kv_prefetch(KVRegs& R, const bf16* Kp, const bf16* Vp, size_t rs, int tid) {
    const size_t o0 = (size_t)(tid >> 4) * rs + (tid & 15) * 8, o1 = o0 + 32 * rs;
    R.k0 = *(const v4u*)(Kp + o0); R.k1 = *(const v4u*)(Kp + o1); R.v0 = *(const v4u*)(Vp + o0); R.v1 = *(const v4u*)(Vp + o1);
}
DI void kv_store(const KVRegs& R, LAS unsigned char* lds, int tid) {
    const int row = tid >> 4, c = tid & 15;
    *(LAS v4u*)(lds + row * KROWB + c * 16) = R.k0; *(LAS v4u*)(lds + (row + 32) * KROWB + c * 16) = R.k1;
    LAS unsigned char* vb = lds + VOFF + (c >> 2) * VBLK + (c & 3) * 16;
    *(LAS v4u*)(vb + row * 64) = R.v0; *(LAS v4u*)(vb + (row + 32) * 64) = R.v1;
}

DI void att_finish(const f32x16 (&o)[4], float m, float l, int lane, int mode, const bf16* gate_row, bf16* out_row, float* lse_p) {
    const int h = lane >> 5;
    const float lt = l + __shfl_xor(l, 32), inv = 1.f / lt;
    if (mode == 1 && h == 0) *lse_p = m + __builtin_amdgcn_logf(lt);
#pragma unroll
    for (int d = 0; d < 4; ++d)
#pragma unroll
        for (int g = 0; g < 4; ++g) {
            const int dd = 32 * d + 8 * g + 4 * h;
            float a0 = o[d][4 * g] * inv, a1 = o[d][4 * g + 1] * inv, a2 = o[d][4 * g + 2] * inv, a3 = o[d][4 * g + 3] * inv;
            if (mode == 0) { const v2u gt = *(const v2u*)(gate_row + dd);
                a0 *= silu(bf_lo(gt.x)); a1 *= silu(bf_hi(gt.x)); a2 *= silu(bf_lo(gt.y)); a3 *= silu(bf_hi(gt.y)); }
            v2u w; w.x = cvtpk(a0, a1); w.y = cvtpk(a2, a3);
            *(v2u*)(out_row + dd) = w;
        }
}

DI void band_unit(LAS unsigned char* lds, const bf16* Qp, size_t q_rs, const bf16* Kp, const bf16* Vp, size_t kv_rs, int Lk, int i0, int w,
                  float m_init, float l_init, int mode, const bf16* gate_p, size_t gate_rs, bf16* out_p, size_t out_rs, float* lse_p, size_t lse_rs) {
    int tid = threadIdx.x; asm volatile("" : "+v"(tid)); const int lane = tid & 63, wid = __builtin_amdgcn_readfirstlane(tid >> 6), h = lane >> 5, ql = lane & 31;
    const int qw0 = i0 + wid * 32, qi = qw0 + ql;
    bf16x8 qf[8];
    { const bf16* qrow = Qp + (size_t)qi * q_rs + 8 * h;
#pragma unroll
      for (int kk = 0; kk < 8; ++kk) qf[kk] = *(const bf16x8*)(qrow + 16 * kk); }
    int jlo = i0 - w; if (jlo < 0) jlo = 0; jlo &= ~63;
    int jhi = i0 + 255 + w; if (jhi > Lk - 1) jhi = Lk - 1;
    const int nt = (jhi >> 6) - (jlo >> 6) + 1;
    f32x16 o[4];
#pragma unroll
    for (int d = 0; d < 4; ++d)
#pragma unroll
        for (int i = 0; i < 16; ++i) o[d][i] = 0.f;
    float m = m_init, l = (h == 0) ? l_init : 0.f;
    const ldsc kp = (ldsc)lds + ql * KROWB + h * 16;
    const ldsc vp = (ldsc)lds + VOFF + (4 * h + ((lane & 15) >> 2)) * 64 + 8 * (4 * ((lane >> 4) & 1) + (lane & 3));
    KVRegs R;
    kv_prefetch(R, Kp + (size_t)jlo * kv_rs, Vp + (size_t)jlo * kv_rs, kv_rs, tid);
    for (int t = 0; t < nt; ++t) {
        const int j0 = jlo + 64 * t;
        __syncthreads();
        kv_store(R, lds, tid);
        __syncthreads();
        if (t + 1 < nt) kv_prefetch(R, Kp + (size_t)(j0 + 64) * kv_rs, Vp + (size_t)(j0 + 64) * kv_rs, kv_rs, tid);
#pragma unroll
        for (int sub = 0; sub < 2; ++sub) {
            const int js = j0 + 32 * sub;
            if (js + 31 < qw0 - w || js > qw0 + 31 + w) continue;
            const BandMask mf{js + 4 * h - qi, w, 2u * (unsigned)w, nullptr};
            att_subtile(kp + sub * 32 * KROWB, vp + sub * 32 * 64, qf, o, m, l, mf);
        }
    }
    att_finish(o, m, l, lane, mode, gate_p + (size_t)qi * gate_rs, out_p + (size_t)qi * out_rs, lse_p + (size_t)qi * lse_rs);
}

DI void nbr_unit(LAS unsigned char* lds, const bf16* Qp, const bf16* Kp, const bf16* Vp, size_t rs, const float* rpb_h, int R,
                 const bf16* gate_p, bf16* y_p) {
    int tid = threadIdx.x; asm volatile("" : "+v"(tid)); const int lane = tid & 63, wid = __builtin_amdgcn_readfirstlane(tid >> 6), h = lane >> 5, ql = lane & 31;
    const int qr = 4 * R + (ql >> 3), qc = 8 * wid + (ql & 7), tok = qr * 64 + qc;
    int rs_ = qr - 4; rs_ = rs_ < 0 ? 0 : (rs_ > 56 ? 56 : rs_);
    int cs_ = qc - 8; cs_ = cs_ < 0 ? 0 : (cs_ > 48 ? 48 : cs_);
    int c0 = 8 * wid - 8; c0 = c0 < 0 ? 0 : (c0 > 32 ? 32 : c0);
    int kr_lo = 4 * R - 4; kr_lo = kr_lo < 0 ? 0 : (kr_lo > 56 ? 56 : kr_lo);
    int kr_hi = 4 * R - 1; kr_hi = (kr_hi < 0 ? 0 : (kr_hi > 56 ? 56 : kr_hi)) + 7;
    const int nt = kr_hi - kr_lo + 1;
    bf16x8 qf[8];
    { const bf16* qrow = Qp + (size_t)tok * rs + 8 * h;
#pragma unroll
      for (int kk = 0; kk < 8; ++kk) qf[kk] = *(const bf16x8*)(qrow + 16 * kk); }
    LAS float* bias = (LAS float*)(lds + BOFF);
    __syncthreads();
    if (tid < 465) bias[tid] = rpb_h[tid] * LOG2E;
    f32x16 o[4];
#pragma unroll
    for (int d = 0; d < 4; ++d)
#pragma unroll
        for (int i = 0; i < 16; ++i) o[d][i] = 0.f;
    float m = -1e30f, l = 0.f;
    const ldsc kp = (ldsc)lds + (c0 + ql) * KROWB + h * 16;
    const ldsc vp = (ldsc)lds + VOFF + (c0 + 4 * h + ((lane & 15) >> 2)) * 64 + 8 * (4 * ((lane >> 4) & 1) + (lane & 3));
    KVRegs Rg;
    kv_prefetch(Rg, Kp + (size_t)(kr_lo * 64) * rs, Vp + (size_t)(kr_lo * 64) * rs, rs, tid);
    for (int t = 0; t < nt; ++t) {
        const int kr = kr_lo + t;
        __syncthreads();
        kv_store(Rg, lds, tid);
        __syncthreads();
        if (t + 1 < nt) kv_prefetch(Rg, Kp + (size_t)((kr + 1) * 64) * rs, Vp + (size_t)((kr + 1) * 64) * rs, rs, tid);
        const NbrMask mf{(unsigned)(kr - rs_) < 8u, c0 + 4 * h, cs_, (kr - qr + 7) * 31 + 15 - qc, bias};
        att_subtile(kp, vp, qf, o, m, l, mf);
    }
    att_finish(o, m, l, lane, 0, gate_p + (size_t)tok * rs, y_p + (size_t)tok * DINNER, nullptr);
}

DI void ln_rows(const float* z, float* xo, bf16* xn, const float* g, const float* b, int nrows, int gw, int ngw, int lane) {
    f32x4 gv[4], bv[4];
#pragma unroll
    for (int j = 0; j < 4; ++j) { gv[j] = *((const f32x4*)g + lane + 64 * j); bv[j] = *((const f32x4*)b + lane + 64 * j); }
    for (int r = gw; r < nrows; r += ngw) {
        const f32x4* zr = (const f32x4*)(z + (size_t)r * DM) + lane;
        f32x4 v[4]; float s = 0.f;
#pragma unroll
        for (int j = 0; j < 4; ++j) { v[j] = zr[64 * j]; s += (v[j][0] + v[j][1]) + (v[j][2] + v[j][3]); }
        const float mean = wave_sum(s) * (1.f / DM); float s2 = 0.f;
#pragma unroll
        for (int j = 0; j < 4; ++j) { v[j] = v[j] - mean; s2 += (v[j][0] * v[j][0] + v[j][1] * v[j][1]) + (v[j][2] * v[j][2] + v[j][3] * v[j][3]); }
        const float rstd = 1.f / sqrtf(wave_sum(s2) * (1.f / DM) + LN_EPS);
        f32x4* xr = (f32x4*)(xo + (size_t)r * DM) + lane;
        v2u* nr = (v2u*)(xn + (size_t)r * DM) + lane;
#pragma unroll
        for (int j = 0; j < 4; ++j) { const f32x4 y = v[j] * rstd * gv[j] + bv[j]; xr[64 * j] = y;
            v2u w; w.x = cvtpk(y[0], y[1]); w.y = cvtpk(y[2], y[3]); nr[64 * j] = w; }
    }
}
DI void combine_b(const bf16* proj, const float* lse, bf16* y, size_t gtid, size_t gn) {
    const size_t total = (size_t)CM * MIXH * 16;
    for (size_t i = gtid; i < total; i += gn) {
        const size_t row = i / 192; const int rem = (int)(i % 192), hh = rem >> 4, c = rem & 15;
        const float l0 = lse[row * 12 + hh], l1 = lse[(size_t)CM * 12 + row * 12 + hh], l2 = lse[(size_t)2 * CM * 12 + row * 12 + hh];
        const float mx = fmaxf(l0, fmaxf(l1, l2));
        float w0 = __builtin_amdgcn_exp2f(l0 - mx), w1 = __builtin_amdgcn_exp2f(l1 - mx), w2 = __builtin_amdgcn_exp2f(l2 - mx);
        const float inv = 1.f / (w0 + w1 + w2); w0 *= inv; w1 *= inv; w2 *= inv;
        const bf16* pr = proj + row * N_B + hh * 128 + c * 8;
        const v4u a = *(const v4u*)pr, b = *(const v4u*)(pr + 12 * 128), d = *(const v4u*)(pr + 24 * 128), gt = *(const v4u*)(pr + 8192);
        v4u o;
#pragma unroll
        for (int e = 0; e < 4; ++e) {
            const float lo = (w0 * bf_lo(a[e]) + w1 * bf_lo(b[e]) + w2 * bf_lo(d[e])) * silu(bf_lo(gt[e]));
            const float hi = (w0 * bf_hi(a[e]) + w1 * bf_hi(b[e]) + w2 * bf_hi(d[e])) * silu(bf_hi(gt[e]));
            o[e] = cvtpk(lo, hi);
        }
        *(v4u*)(y + row * DINNER + hh * 128 + c * 8) = o;
    }
}

constexpr int LDS_PHASE = 131072, LDS_BYTES = LDS_PHASE + 256;
__global__ void __launch_bounds__(NTHR, 2) fwd_megakernel(Args a) {
    extern __shared__ __attribute__((aligned(16))) unsigned char lds_raw[];
    LAS unsigned char* lds = (LAS unsigned char*)lds_raw;
    cg::grid_group grid = cg::this_grid();
    const int G = gridDim.x, bx = blockIdx.x;
#define TID_VARS int tid = threadIdx.x; asm volatile("" : "+v"(tid)); const int lane = tid & 63, wave = __builtin_amdgcn_readfirstlane(tid >> 6); \
    const int gw = bx * NWAVES + wave, ngw = G * NWAVES; const size_t gtid = (size_t)bx * NTHR + tid, gn = (size_t)G * NTHR; (void)lane; (void)gw; (void)ngw; (void)gtid; (void)gn;
    unsigned char* ws = a.ws;
    float* rope = (float*)(ws + WS_ROPE);
    bf16* win_t = (bf16*)(ws + WS_WIN); bf16* wmkv_t = (bf16*)(ws + WS_WMKV); bf16* wout_t = (bf16*)(ws + WS_WOUT);
    bf16* memb = (bf16*)(ws + WS_MEMB); bf16* mkv = (bf16*)(ws + WS_MKV); bf16* xn = (bf16*)(ws + WS_XN);
    bf16* proj = (bf16*)(ws + WS_PROJ); bf16* ybuf = (bf16*)(ws + WS_Y); float* lse = (float*)(ws + WS_LSE);
    { LAS unsigned* stw = (LAS unsigned*)(lds + LDS_PHASE); if (threadIdx.x < 64) stw[threadIdx.x] = 0u; __syncthreads(); }
    const XcdBarrier bar = xcd_barrier_post((unsigned*)(ws + WS_CTL), (volatile LAS unsigned*)(lds + LDS_PHASE));
#define GRID_BAR() xcd_barrier(bar)

    {
        TID_VARS
        LAS float* scr = (LAS float*)(lds + wave * 16384);
        constexpr int I_A = 16 * 160, I_B = 16 * 320, I_C = 16 * 224, I_M = 16 * 32, I_O = 32 * 32;
        constexpr int NIT = 2 * I_A + I_B + I_C + 4 * I_M + 4 * I_O;
        for (int it = gw; it < NIT; it += ngw) {
            int r = it;
            if (r < I_A) { p0_transpose_item(a.w_in_a, DM, N_A, win_t, 0, scr, r, lane); continue; } r -= I_A;
            if (r < I_B) { p0_transpose_item(a.w_in_b, DM, N_B, win_t + (size_t)N_A * DM, 0, scr, r, lane); continue; } r -= I_B;
            if (r < I_C) { p0_transpose_item(a.w_in_c, DM, N_C, win_t + (size_t)(N_A + N_B) * DM, 0, scr, r, lane); continue; } r -= I_C;
            if (r < I_A) { p0_transpose_item(a.w_in_a + (size_t)DM * N_A, DM, N_A, win_t + (size_t)(N_A + N_B + N_C) * DM, 0, scr, r, lane); continue; } r -= I_A;
            if (r < 4 * I_M) { const int li = r / I_M; p0_transpose_item(a.w_mkv + (size_t)li * DM * 1024, DM, 1024, wmkv_t, li * 1024, scr, r % I_M, lane); continue; } r -= 4 * I_M;
            { const int li = r / I_O; p0_transpose_item(a.w_out + (size_t)li * DINNER * DM, DINNER, DM, wout_t + (size_t)li * DM * DINNER, 0, scr, r % I_O, lane); }
        }
        for (size_t i = gtid; i < (size_t)SEQ * 16; i += gn) {
            const int pos = (int)(i >> 4), k = (int)(i & 15);
            const float inv = powf(500000.0f, -(float)k / 16.0f);
            const float ang = (float)pos * inv;
            rope[2 * i] = cosf(ang); rope[2 * i + 1] = sinf(ang);
        }
        cvt_rows(a.mem, memb, (size_t)NB * MEML * DM / 8, gtid, gn);
        cvt_rows(a.x, xn, (size_t)NTOK * DM / 8, gtid, gn);
    }
    grid.sync();
    {
        pg8::Gemm g{memb, wmkv_t, NB * MEML, 4 * 1024, DM}; pg8::StaticOrder S; S.init(NB * MEML, 4 * 1024, G, bx);
        EpiProj E{mkv, 4 * 1024, 0, 0, 1 << 30, rope};
        pg8::gemm_phase<EpiProj, pg8::StaticOrder, true, true>(lds, g, S, E);
    }
    for (int c = 0; c < NCHUNK; ++c) {
        for (int l = 0; l < DEPTH; ++l) {
            const int kind = (l == 3) ? 0 : l;
            const int N = kind == 0 ? N_A : (kind == 1 ? N_B : N_C);
            const size_t woff = (l == 0) ? 0 : (l == 1 ? (size_t)N_A : (l == 2 ? (size_t)(N_A + N_B) : (size_t)(N_A + N_B + N_C)));
            const int q_end = kind == 1 ? 4608 : 1536;
            const int rope_end = kind == 0 ? 2048 : (kind == 1 ? 6144 : 0);
            const int k_off = q_end, v_off = kind == 0 ? 2048 : (kind == 1 ? 6144 : 3072);
            const int mq_off = kind == 0 ? 2560 : (kind == 1 ? 7680 : 4608), gate_off = mq_off + 512;
            {
                pg8::Gemm g{xn + (size_t)c * CM * DM, win_t + woff * DM, CM, N, DM}; pg8::StaticOrder S; S.init(CM, N, G, bx);
                EpiProj E{proj, N, rope_end, q_end, mq_off, rope};
                pg8::gemm_phase<EpiProj, pg8::StaticOrder, true, true>(lds, g, S, E);
            }
            GRID_BAR();
            {
                const int nmix = kind == 1 ? CB * MIXH * 48 : CB * MIXH * 16, nmem = CB * MEMH * 16;
                for (int u = bx; u < nmix + nmem; u += G) {
                    if (u >= nmix) {
                        const int v = u - nmix, b = v >> 6, mh = (v >> 4) & 3, blk = v & 15;
                        const bf16* pb = proj + (size_t)b * SEQ * N;
                        const bf16* kp = mkv + (size_t)((c * CB + b) * MEML) * 4096 + l * 1024 + mh * 128;
                        band_unit(lds, pb + mq_off + mh * 128, N, kp, kp + 512, 4096, MEML, blk * 256, 1 << 20, -1e30f, 0.f, 0,
                                  pb + gate_off + (MIXH + mh) * 128, N, ybuf + (size_t)b * SEQ * DINNER + (MIXH + mh) * 128, DINNER, nullptr, 0);
                    } else if (kind == 0) {
                        const int b = u / 192, rem = u % 192, hh = rem >> 4, blk = rem & 15;
                        const bf16* pb = proj + (size_t)b * SEQ * N;
                        const float sk = a.sink_a[(l == 3 ? 12 : 0) + hh] * LOG2E;
                        band_unit(lds, pb + hh * 128, N, pb + k_off + (hh / 3) * 128, pb + v_off + (hh / 3) * 128, N, SEQ, blk * 256, 128, sk, 1.f, 0,
                                  pb + gate_off + hh * 128, N, ybuf + (size_t)b * SEQ * DINNER + hh * 128, DINNER, nullptr, 0);
                    } else if (kind == 1) {
                        const int b = u / 576, rem = u % 576, hh = rem / 48, rem2 = rem % 48, gi = rem2 >> 4, idx = rem2 & 15;
                        const int dil = 1 << (2 * gi), cls = idx & (dil - 1), blk = idx >> (2 * gi);
                        bf16* pb = proj + ((size_t)b * SEQ + cls) * N;
                        bf16* qp = pb + (gi * MIXH + hh) * 128;
                        band_unit(lds, qp, (size_t)dil * N, pb + k_off + hh * 128, pb + v_off + hh * 128, (size_t)dil * N, SEQ / dil, blk * 256, 64, -1e30f, 0.f, 1,
                                  nullptr, 0, qp, (size_t)dil * N, lse + (size_t)gi * CM * 12 + ((size_t)b * SEQ + cls) * 12 + hh, (size_t)dil * 12);
                    } else {
                        const int b = u / 192, rem = u % 192, hh = rem >> 4, R = rem & 15;
                        const bf16* pb = proj + (size_t)b * SEQ * N;
                        nbr_unit(lds, pb + hh * 128, pb + k_off + hh * 128, pb + v_off + hh * 128, N, a.rpb_c + hh * 465, R,
                                 pb + gate_off + hh * 128, ybuf + (size_t)b * SEQ * DINNER + hh * 128);
                    }
                }
            }
            GRID_BAR();
            if (kind == 1) { TID_VARS combine_b(proj, lse, ybuf, gtid, gn); GRID_BAR(); }
            {
                pg8::Gemm g{ybuf, wout_t + (size_t)l * DM * DINNER, CM, DM, DINNER}; pg8::StaticOrder S; S.init(CM, DM, G, bx);
                EpiResid E{(l == 0 ? a.x : a.out) + (size_t)c * CM * DM, a.out + (size_t)c * CM * DM};
                pg8::gemm_phase<EpiResid, pg8::StaticOrder, true, true>(lds, g, S, E);
            }
            GRID_BAR();
            { TID_VARS ln_rows(a.out + (size_t)c * CM * DM, a.out + (size_t)c * CM * DM, xn + (size_t)c * CM * DM, a.ln_g + l * DM, a.ln_b + l * DM, CM, gw, ngw, lane); }
            GRID_BAR();
        }
    }
}

extern "C" void kernel_launch(void* const* d_in, const int* in_sizes, int n_in, void* d_out, int out_size, void* d_ws, size_t ws_size, hipStream_t stream) {
    static int grid_blocks = 0;
    if (grid_blocks == 0) {
        if (n_in != 11 || ws_size < WS_END) { fprintf(stderr, "kernel_launch: unexpected inputs (n_in %d, ws %zu)\n", n_in, ws_size); grid_blocks = -1; return; }
        int dev = 0, cus = 0, per_cu = 0;
        hipGetDevice(&dev);
        hipDeviceGetAttribute(&cus, hipDeviceAttributeMultiprocessorCount, dev);
        hipFuncSetAttribute((const void*)fwd_megakernel, hipFuncAttributeMaxDynamicSharedMemorySize, LDS_BYTES);
        hipOccupancyMaxActiveBlocksPerMultiprocessor(&per_cu, (const void*)fwd_megakernel, NTHR, LDS_BYTES);
        if (per_cu < 1) per_cu = 1;
        grid_blocks = cus * per_cu;
        fprintf(stderr, "kernel_launch: cus %d per_cu %d grid %d ws %zu\n", cus, per_cu, grid_blocks, ws_size);
    }
    if (grid_blocks < 0) return;
    Args a{};
    a.x = (const float*)d_in[0]; a.mem = (const float*)d_in[1]; a.w_in_a = (const float*)d_in[2]; a.sink_a = (const float*)d_in[3];
    a.w_in_b = (const float*)d_in[4]; a.w_in_c = (const float*)d_in[5]; a.rpb_c = (const float*)d_in[6]; a.w_mkv = (const float*)d_in[7];
    a.w_out = (const float*)d_in[8]; a.ln_g = (const float*)d_in[9]; a.ln_b = (const float*)d_in[10]; a.out = (float*)d_out; a.ws = (unsigned char*)d_ws;
    if (hipMemsetAsync((char*)d_ws + WS_CTL, 0, CTL_ZERO_BYTES, stream) != hipSuccess) { fprintf(stderr, "kernel_launch: memset failed\n"); return; }
    void* args[] = {&a};
    hipError_t e = hipLaunchCooperativeKernel((const void*)fwd_megakernel, dim3(grid_blocks), dim3(NTHR), args, LDS_BYTES, stream);
    if (e != hipSuccess) fprintf(stderr, "cooperative launch failed: %s (grid %d)\n", hipGetErrorString(e), grid_blocks);
}
```
